# Optimizing an MI355X kernel written in HIP

```python
import math
import jax
import jax.numpy as jnp
from jax import lax
import numpy as np

D_MODEL = 1024
BATCH = 8
SEQ = 2048
DEPTH = 4

N_MIXERS = 4
GROUP_WIDTH = D_MODEL // N_MIXERS
HEAD_DIM = 64
GROUP_HEADS = GROUP_WIDTH // HEAD_DIM
MIX_WIDTH = N_MIXERS * GROUP_WIDTH
DILATED_PATTERNS = ((128, 1), (512, 4), (2048, 16))
MLA_Q_RANK = 384
MLA_KV_RANK = 256
MLA_NOPE_DIM = 64
MLA_ROPE_DIM = 32
MLA_V_DIM = HEAD_DIM
DIFF_QK_DIM = HEAD_DIM // 2
DIFF_EPS = 1e-5
GRID_W = 64
NA_WIN_ROWS = 8
NA_WIN_COLS = 16
D_FF = 2816
CONV_WIDTH = 3
PLE_DIM = 256

ROPE_THETA = 10000.0
NORM_EPS = 1e-6
Q_BLOCK = 128
NEG_INF = -1e30

A_COLS = 3 * GROUP_WIDTH
MLA_COLS = MLA_Q_RANK + MLA_KV_RANK + MLA_ROPE_DIM
DIFF_COLS = 2 * (GROUP_HEADS * 2 * DIFF_QK_DIM) + GROUP_WIDTH
NA_COLS = 3 * GROUP_WIDTH
IN_COLS = A_COLS + MLA_COLS + DIFF_COLS + NA_COLS

kernel_name = 'hybrid_parallel_head_group_encoder'


def rms_norm(x, g, eps=NORM_EPS):
    xf = x.astype(jnp.float32)
    y = xf * lax.rsqrt(jnp.mean(xf * xf, axis=-1, keepdims=True) + eps)
    return (y * g.astype(jnp.float32)).astype(x.dtype)


def rope(x, pos):
    d = x.shape[-1]
    inv = jnp.power(ROPE_THETA, -jnp.arange(0, d, 2, dtype=jnp.float32) / d)
    ang = pos.astype(jnp.float32)[:, None] * inv[None, :]
    cos = jnp.cos(ang).astype(x.dtype)
    sin = jnp.sin(ang).astype(x.dtype)
    x1, x2 = jnp.split(x, 2, axis=-1)
    return jnp.concatenate([x1 * cos - x2 * sin, x1 * sin + x2 * cos], axis=-1)


def split_heads(t, n):
    b, s, _ = t.shape
    return t.reshape(b, s, n, -1).transpose(0, 2, 1, 3)


def merge_heads(t):
    b, h, s, d = t.shape
    return t.transpose(0, 2, 1, 3).reshape(b, s, h * d)


def softmax_f32(s):
    return jax.nn.softmax(s.astype(jnp.float32), axis=-1)


def block_sweep(f, *qs):
    b, h, s, _ = qs[0].shape
    nb = s // Q_BLOCK
    blocks = tuple(jnp.moveaxis(q.reshape(b, h, nb, Q_BLOCK, q.shape[-1]), 2, 0) for q in qs)
    out = lax.map(lambda args: f(*args), blocks)
    out = jnp.moveaxis(out, 0, 2)
    return out.reshape(b, h, s, out.shape[-1])


def banded_attn(q, k, v, radius):
    lead = q.shape[:-2]
    L, d = q.shape[-2:]
    nb = -(-L // radius)
    lp = nb * radius
    zeros = [(0, 0)] * len(lead)
    qb = jnp.pad(q, zeros + [(0, lp - L), (0, 0)]).reshape(*lead, nb, radius, d)

    def windows(t):
        tb = jnp.pad(t, zeros + [(radius, lp - L + radius), (0, 0)])
        tb = tb.reshape(*lead, nb + 2, radius, t.shape[-1])
        return jnp.concatenate([tb[..., :-2, :, :], tb[..., 1:-1, :, :], tb[..., 2:, :, :]], axis=-2)

    kw, vw = windows(k), windows(v)
    s = jnp.einsum('...nqd,...nkd->...nqk', qb, kw).astype(jnp.float32) * (d ** -0.5)
    blk = jnp.arange(nb)[:, None, None] * radius
    qpos = blk + jnp.arange(radius)[None, :, None]
    kpos = blk - radius + jnp.arange(3 * radius)[None, None, :]
    mask = (jnp.abs(kpos - qpos) <= radius) & (kpos >= 0) & (kpos < L)
    s = jnp.where(mask, s, NEG_INF)
    lse = jax.nn.logsumexp(s, axis=-1)
    prob = jnp.exp(s - lse[..., None])
    out = jnp.einsum('...nqk,...nkd->...nqd', prob.astype(v.dtype), vw)
    return out.reshape(*lead, lp, d)[..., :L, :], lse.reshape(*lead, lp)[..., :L]


def dilated_mixture(q, k, v):
    b, h, s, d = q.shape
    outs, lses = [], []
    for window, dil in DILATED_PATTERNS:
        radius = window // (2 * dil)

        def to_residue(t):
            return t.reshape(b, h, s // dil, dil, t.shape[-1]).swapaxes(2, 3)

        o, l = banded_attn(to_residue(q), to_residue(k), to_residue(v), radius)
        outs.append(o.swapaxes(2, 3).reshape(b, h, s, d))
        lses.append(l.swapaxes(2, 3).reshape(b, h, s))
    wts = jax.nn.softmax(jnp.stack(lses), axis=0)
    out = jnp.sum(wts[..., None] * jnp.stack(outs).astype(jnp.float32), axis=0)
    return out.astype(q.dtype)


def mla_mixer(cols, q_norm, w_uq, kv_norm, w_ukv, pos):
    c_q, c_kv, k_rope = jnp.split(cols, [MLA_Q_RANK, MLA_Q_RANK + MLA_KV_RANK], axis=-1)
    q = split_heads(rms_norm(c_q, q_norm) @ w_uq, GROUP_HEADS)
    q_nope, q_rot = jnp.split(q, [MLA_NOPE_DIM], axis=-1)
    q = jnp.concatenate([q_nope, rope(q_rot, pos)], axis=-1)
    kv = split_heads(rms_norm(c_kv, kv_norm) @ w_ukv, GROUP_HEADS)
    k_nope, v = jnp.split(kv, [MLA_NOPE_DIM], axis=-1)
    k_r = rope(k_rope[:, None], pos)
    k = jnp.concatenate([k_nope, jnp.broadcast_to(k_r, k_nope.shape[:-1] + (MLA_ROPE_DIM,))], axis=-1)
    scale = (MLA_NOPE_DIM + MLA_ROPE_DIM) ** -0.5

    def attend(qb):
        pr = softmax_f32(jnp.einsum('bhqd,bhkd->bhqk', qb, k).astype(jnp.float32) * scale)
        return jnp.einsum('bhqk,bhkd->bhqd', pr.astype(v.dtype), v)

    return block_sweep(attend, q)


def diff_mixer(cols, lam_q1, lam_k1, lam_q2, lam_k2, subln, lam_init, pos):
    qk_w = GROUP_HEADS * 2 * DIFF_QK_DIM
    q, k, v = jnp.split(cols, [qk_w, 2 * qk_w], axis=-1)
    b, s, _ = q.shape
    q = rope(split_heads(q, 2 * GROUP_HEADS), pos).reshape(b, GROUP_HEADS, 2, s, DIFF_QK_DIM)
    k = rope(split_heads(k, 2 * GROUP_HEADS), pos).reshape(b, GROUP_HEADS, 2, s, DIFF_QK_DIM)
    v = split_heads(v, GROUP_HEADS)
    q1, q2 = q[:, :, 0], q[:, :, 1]
    k1, k2 = k[:, :, 0], k[:, :, 1]
    lam = (jnp.exp(jnp.sum(lam_q1.astype(jnp.float32) * lam_k1.astype(jnp.float32)))
           - jnp.exp(jnp.sum(lam_q2.astype(jnp.float32) * lam_k2.astype(jnp.float32))) + lam_init)
    scale = DIFF_QK_DIM ** -0.5

    def attend(q1b, q2b):
        p1 = softmax_f32(jnp.einsum('bhqd,bhkd->bhqk', q1b, k1).astype(jnp.float32) * scale)
        p2 = softmax_f32(jnp.einsum('bhqd,bhkd->bhqk', q2b, k2).astype(jnp.float32) * scale)
        return jnp.einsum('bhqk,bhkd->bhqd', (p1 - lam * p2).astype(v.dtype), v)

    o = block_sweep(attend, q1, q2)
    return rms_norm(o, subln, DIFF_EPS) * (1.0 - lam_init)


def neighbourhood_attn(q, k, v, rpb):
    b, h, s, d = q.shape
    rows = s // GRID_W
    kr = min(NA_WIN_ROWS, rows)
    q = q.reshape(b, h, rows, GRID_W, d)
    k = k.reshape(b, h, rows, GRID_W, d)
    v = v.reshape(b, h, rows, GRID_W, d)
    r = jnp.arange(rows)
    key_rows = jnp.clip(r - kr // 2, 0, rows - kr)[:, None] + jnp.arange(kr)[None, :]
    kg = k[:, :, key_rows]
    vg = v[:, :, key_rows]
    sc = jnp.einsum('bhrqd,bhrjkd->bhrqjk', q, kg).astype(jnp.float32) * (d ** -0.5)
    c = jnp.arange(GRID_W)
    c_start = jnp.clip(c - NA_WIN_COLS // 2, 0, GRID_W - NA_WIN_COLS)
    col_ok = (c[None, :] >= c_start[:, None]) & (c[None, :] < c_start[:, None] + NA_WIN_COLS)
    dr = key_rows - r[:, None]
    dc = jnp.clip(c[None, :] - c[:, None], -(NA_WIN_COLS - 1), NA_WIN_COLS - 1)
    idx_r = dr[:, None, :, None] + (NA_WIN_ROWS - 1)
    idx_c = dc[None, :, None, :] + (NA_WIN_COLS - 1)
    bias = rpb[:, idx_r, idx_c].astype(jnp.float32)
    sc = jnp.where(col_ok[None, None, None, :, None, :], sc + bias[None], NEG_INF)
    pr = softmax_f32(sc.reshape(b, h, rows, GRID_W, kr * GRID_W)).reshape(sc.shape)
    o = jnp.einsum('bhrqjk,bhrjkd->bhrqd', pr.astype(v.dtype), vg)
    return o.reshape(b, h, s, d)


def dwconv_centred(u, w, bias):
    s = u.shape[1]
    half = CONV_WIDTH // 2
    up = jnp.pad(u, ((0, 0), (half, CONV_WIDTH - 1 - half), (0, 0)))
    return sum(up[:, j:j + s] * w[j] for j in range(CONV_WIDTH)) + bias


def setup_inputs(seed: int = 0) -> dict:
    key = jax.random.key(seed)
    ks = jax.random.split(key, 24)

    def nrm(k, shape, scale):
        return jax.random.normal(k, shape, jnp.float32) * scale

    def gain(k, shape):
        return 1.0 + nrm(k, shape, 0.01)

    return {
        'x': nrm(ks[0], (BATCH, SEQ, D_MODEL), 1.0),
        'p': nrm(ks[1], (DEPTH, BATCH, SEQ, PLE_DIM), 1.0),
        'attn_norm': gain(ks[2], (DEPTH, D_MODEL)),
        'w_in': nrm(ks[3], (DEPTH, D_MODEL, IN_COLS), D_MODEL ** -0.5),
        'mla_q_norm': gain(ks[4], (DEPTH, MLA_Q_RANK)),
        'w_uq': nrm(ks[5], (DEPTH, MLA_Q_RANK, GROUP_HEADS * (MLA_NOPE_DIM + MLA_ROPE_DIM)), MLA_Q_RANK ** -0.5),
        'mla_kv_norm': gain(ks[6], (DEPTH, MLA_KV_RANK)),
        'w_ukv': nrm(ks[7], (DEPTH, MLA_KV_RANK, GROUP_HEADS * (MLA_NOPE_DIM + MLA_V_DIM)), MLA_KV_RANK ** -0.5),
        'lam_q1': nrm(ks[8], (DEPTH, DIFF_QK_DIM), 0.1),
        'lam_k1': nrm(ks[9], (DEPTH, DIFF_QK_DIM), 0.1),
        'lam_q2': nrm(ks[10], (DEPTH, DIFF_QK_DIM), 0.1),
        'lam_k2': nrm(ks[11], (DEPTH, DIFF_QK_DIM), 0.1),
        'diff_subln': gain(ks[12], (DEPTH, HEAD_DIM)),
        'na_rpb': nrm(ks[13], (DEPTH, GROUP_HEADS, 2 * NA_WIN_ROWS - 1, 2 * NA_WIN_COLS - 1), 0.1),
        'w_o': nrm(ks[14], (DEPTH, MIX_WIDTH, D_MODEL), MIX_WIDTH ** -0.5),
        'ffn_norm': gain(ks[15], (DEPTH, D_MODEL)),
        'w_up': nrm(ks[16], (DEPTH, D_MODEL, 2 * D_FF), D_MODEL ** -0.5),
        'conv_w': nrm(ks[17], (DEPTH, CONV_WIDTH, 2 * D_FF), CONV_WIDTH ** -0.5),
        'conv_b': nrm(ks[18], (DEPTH, 2 * D_FF), 0.01),
        'w_down': nrm(ks[19], (DEPTH, D_FF, D_MODEL), D_FF ** -0.5),
        'ple_norm': gain(ks[20], (DEPTH, D_MODEL)),
        'w_ple_gate': nrm(ks[21], (DEPTH, D_MODEL, D_MODEL), D_MODEL ** -0.5),
        'w_ple_proj': nrm(ks[22], (DEPTH, PLE_DIM, D_MODEL), PLE_DIM ** -0.5),
        'final_norm': gain(ks[23], (D_MODEL,)),
    }


def reference(x, p, attn_norm, w_in, mla_q_norm, w_uq, mla_kv_norm, w_ukv, lam_q1, lam_k1, lam_q2, lam_k2,
              diff_subln, na_rpb, w_o, ffn_norm, w_up, conv_w, conv_b, w_down, ple_norm, w_ple_gate,
              w_ple_proj, final_norm):
    s = x.shape[1]
    pos = jnp.arange(s, dtype=jnp.int32)
    split_at = [A_COLS, A_COLS + MLA_COLS, A_COLS + MLA_COLS + DIFF_COLS]
    h = x
    for i in range(DEPTH):
        hn = rms_norm(h, attn_norm[i])
        cols = hn @ w_in[i]
        a_cols, b_cols, c_cols, d_cols = jnp.split(cols, split_at, axis=-1)
        qa, ka, va = (split_heads(t, GROUP_HEADS) for t in jnp.split(a_cols, 3, axis=-1))
        o_a = dilated_mixture(rope(qa, pos), rope(ka, pos), va)
        o_b = mla_mixer(b_cols, mla_q_norm[i], w_uq[i], mla_kv_norm[i], w_ukv[i], pos)
        lam_init = 0.8 - 0.6 * math.exp(-0.3 * i)
        o_c = diff_mixer(c_cols, lam_q1[i], lam_k1[i], lam_q2[i], lam_k2[i], diff_subln[i], lam_init, pos)
        qd, kd, vd = (split_heads(t, GROUP_HEADS) for t in jnp.split(d_cols, 3, axis=-1))
        o_d = neighbourhood_attn(qd, kd, vd, na_rpb[i])
        mix = jnp.concatenate([merge_heads(o) for o in (o_a, o_b, o_c, o_d)], axis=-1)
        h = h + mix @ w_o[i]
        hn = rms_norm(h, ffn_norm[i])
        u = dwconv_centred(hn @ w_up[i], conv_w[i], conv_b[i])
        gate, val = jnp.split(u, 2, axis=-1)
        h = h + (jax.nn.gelu(gate) * val) @ w_down[i]
        e = p[i] @ w_ple_proj[i]
        g = jax.nn.sigmoid(rms_norm(h, ple_norm[i]) @ w_ple_gate[i])
        h = h + g * e
    return rms_norm(h, final_norm)
```

```cpp
#include <hip/hip_runtime.h>
#include <cmath>
#include <cstdio>
#include <cstdint>

constexpr int DM = 1024, NB = 8, SEQ = 2048, DEPTH = 4, MTOK = NB * SEQ;
constexpr int IN_COLS = 2976, DFF = 2816, PLE = 256;
constexpr int OFF_A = 0, OFF_B = 768, OFF_C = 1440, OFF_D = 2208;
constexpr int GR = 4096;
constexpr int NGRP = MTOK / GR;

__global__ void k_tab(float* tab) {
    const int j = threadIdx.x;
    if (j < 32) tab[j] = (float)exp(-((double)(2 * j) / 64.0) * 9.21034037197618273607);
    else if (j < 48) tab[j] = (float)exp(-((double)(2 * (j - 32)) / 32.0) * 9.21034037197618273607);
}

__device__ __forceinline__ void sincos_acc(float ang, float& s, float& c) {
    const double a = (double)ang;
    const double k = rint(a * 0.63661977236758134308);
    double r = fma(-k, 1.57079632679489655800, a);
    r = fma(-k, 6.12323399573676603587e-17, r);
    const int q = ((int)k) & 3;
    const double r2 = r * r;
    const double sp = r * (1.0 + r2 * (-1.0 / 6 + r2 * (1.0 / 120 + r2 * (-1.0 / 5040 + r2 * (1.0 / 362880 + r2 * (-1.0 / 39916800 + r2 * (1.0 / 6227020800.0)))))));
    const double cp = 1.0 + r2 * (-0.5 + r2 * (1.0 / 24 + r2 * (-1.0 / 720 + r2 * (1.0 / 40320 + r2 * (-1.0 / 3628800 + r2 * (1.0 / 479001600 + r2 * (-1.0 / 87178291200.0)))))));
    double sv, cv;
    if (q == 0) { sv = sp; cv = cp; } else if (q == 1) { sv = cp; cv = -sp; } else if (q == 2) { sv = -sp; cv = -cp; } else { sv = -cp; cv = sp; }
    s = (float)sv; c = (float)cv;
}

__device__ __forceinline__ float wave_sum(float v) {
#pragma unroll
    for (int o = 1; o < 64; o <<= 1) v += __shfl_xor(v, o);
    return v;
}
__device__ __forceinline__ float g16_sum(float v) {
    v += __shfl_xor(v, 1); v += __shfl_xor(v, 2); v += __shfl_xor(v, 4); v += __shfl_xor(v, 8);
    return v;
}

__global__ void __launch_bounds__(256) k_rmsnorm(const float* x, int ldx, const float* g, float* y, int ldy, int rows, int D, float eps, float post) {
    const int wave = (blockIdx.x * 256 + threadIdx.x) >> 6, lane = threadIdx.x & 63;
    if (wave >= rows) return;
    const float* xr = x + (size_t)wave * ldx; float* yr = y + (size_t)wave * ldy;
    float s = 0.f;
    for (int i = lane; i < D; i += 64) { const float v = xr[i]; s += v * v; }
    s = wave_sum(s);
    const float rs = 1.0f / sqrtf(s / (float)D + eps);
    for (int i = lane; i < D; i += 64) yr[i] = xr[i] * rs * g[i] * post;
}

template <bool ACCUM>
__global__ void __launch_bounds__(256) k_gemm(const float* __restrict__ A, int lda, const float* __restrict__ W, int ldw, float* C, int ldc, int N, int K) {
    __shared__ float As[8][132];
    __shared__ float Ws[8][132];
    const int t = threadIdx.x, tx = t & 15, ty = t >> 4;
    const int row0 = blockIdx.y * 128, col0 = blockIdx.x * 128;
    float acc[8][8];
#pragma unroll
    for (int i = 0; i < 8; ++i)
#pragma unroll
        for (int j = 0; j < 8; ++j) acc[i][j] = 0.f;
    const int ar = t >> 1, ak = (t & 1) * 4;
    const int wk = t >> 5, wc = (t & 31) * 4;
    for (int k0 = 0; k0 < K; k0 += 8) {
        const float4 av = *(const float4*)(A + (size_t)(row0 + ar) * lda + k0 + ak);
        float4 wv = make_float4(0.f, 0.f, 0.f, 0.f);
        if (col0 + wc < N) wv = *(const float4*)(W + (size_t)(k0 + wk) * ldw + col0 + wc);
        __syncthreads();
        As[ak + 0][ar] = av.x; As[ak + 1][ar] = av.y; As[ak + 2][ar] = av.z; As[ak + 3][ar] = av.w;
        Ws[wk][wc + 0] = wv.x; Ws[wk][wc + 1] = wv.y; Ws[wk][wc + 2] = wv.z; Ws[wk][wc + 3] = wv.w;
        __syncthreads();
#pragma unroll
        for (int kk = 0; kk < 8; ++kk) {
            float a[8], b[8];
#pragma unroll
            for (int i = 0; i < 8; ++i) a[i] = As[kk][ty * 8 + i];
#pragma unroll
            for (int j = 0; j < 8; ++j) b[j] = Ws[kk][tx * 8 + j];
#pragma unroll
            for (int i = 0; i < 8; ++i)
#pragma unroll
                for (int j = 0; j < 8; ++j) acc[i][j] = fmaf(a[i], b[j], acc[i][j]);
        }
    }
#pragma unroll
    for (int i = 0; i < 8; ++i) {
        float* cr = C + (size_t)(row0 + ty * 8 + i) * ldc + col0 + tx * 8;
#pragma unroll
        for (int j = 0; j < 8; ++j) {
            if (col0 + tx * 8 + j < N) { if (ACCUM) cr[j] += acc[i][j]; else cr[j] = acc[i][j]; }
        }
    }
}

__global__ void __launch_bounds__(256) k_rope(float* buf, int ld, int col0, int nh, int d, int hs, int rows, int row0, const float* tab) {
    const int half = d >> 1;
    const int per_row = nh * half;
    const int idx = blockIdx.x * 256 + threadIdx.x;
    if (idx >= rows * per_row) return;
    const int r = idx / per_row, rem = idx % per_row, hh = rem / half, j = rem % half;
    const int pos = (row0 + r) % SEQ;
    const float inv = (d == 64) ? tab[j] : tab[32 + j];
    const float ang = (float)pos * inv;
    float s, c; sincos_acc(ang, s, c);
    float* p = buf + (size_t)r * ld + col0 + hh * hs;
    const float x1 = p[j], x2 = p[j + half];
    p[j] = x1 * c - x2 * s;
    p[j + half] = x1 * s + x2 * c;
}

__global__ void __launch_bounds__(256) k_mix_a(const float* cols, float* mix, int rows) {
    const int gid = (blockIdx.x * 256 + threadIdx.x) >> 4, l = threadIdx.x & 15;
    const int h = gid / rows, r = gid % rows;
    if (h >= 4) return;
    const int pos = r % SEQ, base = r - pos;
    const float4 q = *(const float4*)(cols + (size_t)r * IN_COLS + OFF_A + h * 64 + l * 4);
    float4 op[3]; float lse[3];
    const int dils[3] = {1, 4, 16};
#pragma unroll
    for (int p = 0; p < 3; ++p) {
        const int dil = dils[p], L = SEQ / dil, nq = pos / dil, rho = pos % dil;
        float m = -INFINITY, lsum = 0.f; float4 o = make_float4(0.f, 0.f, 0.f, 0.f);
        for (int dl = -64; dl <= 64; ++dl) {
            const int nk = nq + dl;
            if (nk < 0 || nk >= L) continue;
            const size_t kr = (size_t)(base + nk * dil + rho) * IN_COLS;
            const float4 k = *(const float4*)(cols + kr + OFF_A + 256 + h * 64 + l * 4);
            float s = q.x * k.x + q.y * k.y + q.z * k.z + q.w * k.w;
            s = g16_sum(s) * 0.125f;
            const float mn = fmaxf(m, s), f = expf(m - mn), e = expf(s - mn);
            const float4 v = *(const float4*)(cols + kr + OFF_A + 512 + h * 64 + l * 4);
            o.x = o.x * f + e * v.x; o.y = o.y * f + e * v.y; o.z = o.z * f + e * v.z; o.w = o.w * f + e * v.w;
            lsum = lsum * f + e; m = mn;
        }
        const float il = 1.0f / lsum;
        op[p] = make_float4(o.x * il, o.y * il, o.z * il, o.w * il);
        lse[p] = m + logf(lsum);
    }
    const float mm = fmaxf(lse[0], fmaxf(lse[1], lse[2]));
    const float w0 = expf(lse[0] - mm), w1 = expf(lse[1] - mm), w2 = expf(lse[2] - mm), iw = 1.0f / (w0 + w1 + w2);
    float4 o;
    o.x = (w0 * op[0].x + w1 * op[1].x + w2 * op[2].x) * iw; o.y = (w0 * op[0].y + w1 * op[1].y + w2 * op[2].y) * iw;
    o.z = (w0 * op[0].z + w1 * op[1].z + w2 * op[2].z) * iw; o.w = (w0 * op[0].w + w1 * op[1].w + w2 * op[2].w) * iw;
    *(float4*)(mix + (size_t)r * DM + 0 + h * 64 + l * 4) = o;
}

__global__ void __launch_bounds__(256) k_mix_b(const float* cols, const float* qb, const float* kvb, float* mix, int rows) {
    const int gid = (blockIdx.x * 256 + threadIdx.x) >> 4, l = threadIdx.x & 15;
    const int h = gid / rows, r = gid % rows;
    if (h >= 4) return;
    const int pos = r % SEQ, base = r - pos;
    const float scale = 1.0f / sqrtf(96.0f);
    const float4 qn = *(const float4*)(qb + (size_t)r * 384 + h * 96 + l * 4);
    const float2 qr = *(const float2*)(qb + (size_t)r * 384 + h * 96 + 64 + l * 2);
    float m = -INFINITY, lsum = 0.f; float4 o = make_float4(0.f, 0.f, 0.f, 0.f);
    for (int j = 0; j < SEQ; ++j) {
        const size_t kr = (size_t)(base + j);
        const float4 kn = *(const float4*)(kvb + kr * 512 + h * 128 + l * 4);
        const float2 kp = *(const float2*)(cols + kr * IN_COLS + OFF_B + 640 + l * 2);
        float s = qn.x * kn.x + qn.y * kn.y + qn.z * kn.z + qn.w * kn.w + qr.x * kp.x + qr.y * kp.y;
        s = g16_sum(s) * scale;
        const float mn = fmaxf(m, s), f = expf(m - mn), e = expf(s - mn);
        const float4 v = *(const float4*)(kvb + kr * 512 + h * 128 + 64 + l * 4);
        o.x = o.x * f + e * v.x; o.y = o.y * f + e * v.y; o.z = o.z * f + e * v.z; o.w = o.w * f + e * v.w;
        lsum = lsum * f + e; m = mn;
    }
    const float il = 1.0f / lsum;
    *(float4*)(mix + (size_t)r * DM + 256 + h * 64 + l * 4) = make_float4(o.x * il, o.y * il, o.z * il, o.w * il);
}

__global__ void __launch_bounds__(256) k_mix_d(const float* cols, const float* rpb, float* mix, int rows) {
    const int gid = (blockIdx.x * 256 + threadIdx.x) >> 4, l = threadIdx.x & 15;
    const int h = gid / rows, r = gid % rows;
    if (h >= 4) return;
    const int pos = r % SEQ, base = r - pos;
    const int gr = pos / 64, gc = pos % 64;
    int rs = gr - 4; rs = rs < 0 ? 0 : (rs > 24 ? 24 : rs);
    int cs = gc - 8; cs = cs < 0 ? 0 : (cs > 48 ? 48 : cs);
    const float4 q = *(const float4*)(cols + (size_t)r * IN_COLS + OFF_D + h * 64 + l * 4);
    float m = -INFINITY, lsum = 0.f; float4 o = make_float4(0.f, 0.f, 0.f, 0.f);
    for (int jr = 0; jr < 8; ++jr)
        for (int jc = 0; jc < 16; ++jc) {
            const int kr_ = rs + jr, kc = cs + jc;
            const size_t krow = (size_t)(base + kr_ * 64 + kc) * IN_COLS;
            const float4 k = *(const float4*)(cols + krow + OFF_D + 256 + h * 64 + l * 4);
            float s = q.x * k.x + q.y * k.y + q.z * k.z + q.w * k.w;
            const int dr = kr_ - gr, dc = kc - gc;
            s = g16_sum(s) * 0.125f + rpb[(h * 15 + (dr + 7)) * 31 + (dc + 15)];
            const float mn = fmaxf(m, s), f = expf(m - mn), e = expf(s - mn);
            const float4 v = *(const float4*)(cols + krow + OFF_D + 512 + h * 64 + l * 4);
            o.x = o.x * f + e * v.x; o.y = o.y * f + e * v.y; o.z = o.z * f + e * v.z; o.w = o.w * f + e * v.w;
            lsum = lsum * f + e; m = mn;
        }
    const float il = 1.0f / lsum;
    *(float4*)(mix + (size_t)r * DM + 768 + h * 64 + l * 4) = make_float4(o.x * il, o.y * il, o.z * il, o.w * il);
}

__global__ void __launch_bounds__(256) k_conv_gelu(const float* U, const float* cw, const float* cb, float* act, int rows) {
    const size_t idx = (size_t)blockIdx.x * 256 + threadIdx.x;
    if (idx >= (size_t)rows * DFF) return;
    const int r = (int)(idx / DFF), c = (int)(idx % DFF);
    const int pos = r % SEQ;
    float u[2];
#pragma unroll
    for (int t = 0; t < 2; ++t) {
        const int cc = c + t * DFF;
        float a = cb[cc] + U[(size_t)r * (2 * DFF) + cc] * cw[1 * 2 * DFF + cc];
        if (pos > 0) a += U[(size_t)(r - 1) * (2 * DFF) + cc] * cw[0 * 2 * DFF + cc];
        if (pos < SEQ - 1) a += U[(size_t)(r + 1) * (2 * DFF) + cc] * cw[2 * 2 * DFF + cc];
        u[t] = a;
    }
    const float x = u[0];
    const float gl = 0.5f * x * (1.0f + tanhf(0.7978845608028654f * (x + 0.044715f * x * x * x)));
    act[idx] = gl * u[1];
}

__global__ void __launch_bounds__(256) k_ple(float* h, const float* g, const float* e, int n) {
    const int idx = blockIdx.x * 256 + threadIdx.x;
    if (idx >= n) return;
    const float s = 1.0f / (1.0f + expf(-g[idx]));
    h[idx] += s * e[idx];
}

__global__ void k_scalar_lam(const float* q1, const float* k1, const float* q2, const float* k2, float lam_init, float* out) {
    if (threadIdx.x == 0 && blockIdx.x == 0) {
        float a = 0.f, b = 0.f;
        for (int i = 0; i < 32; ++i) { a += q1[i] * k1[i]; b += q2[i] * k2[i]; }
        out[0] = expf(a) - expf(b) + lam_init;
    }
}

static void gemm(bool accum, const float* A, int lda, const float* W, int ldw, float* C, int ldc, int R, int N, int K, hipStream_t s) {
    dim3 grid((N + 127) / 128, R / 128);
    if (accum) hipLaunchKernelGGL(k_gemm<true>, grid, dim3(256), 0, s, A, lda, W, ldw, C, ldc, N, K);
    else hipLaunchKernelGGL(k_gemm<false>, grid, dim3(256), 0, s, A, lda, W, ldw, C, ldc, N, K);
}

__global__ void __launch_bounds__(256) k_mix_c2(const float* cols, const float* subln, const float* lamp, float lam_init, float* mix, int rows) {
    const float lam = lamp[0];
    const int gid = (blockIdx.x * 256 + threadIdx.x) >> 4, l = threadIdx.x & 15;
    const int h = gid / rows, r = gid % rows;
    if (h >= 4) return;
    const int pos = r % SEQ, base = r - pos;
    const float scale = 1.0f / sqrtf(32.0f);
    const float* qrow = cols + (size_t)r * IN_COLS + OFF_C;
    const float2 q1 = *(const float2*)(qrow + (2 * h) * 32 + l * 2), q2 = *(const float2*)(qrow + (2 * h + 1) * 32 + l * 2);
    float m1 = -INFINITY, l1 = 0.f, m2 = -INFINITY, l2 = 0.f;
    float4 o1 = make_float4(0.f, 0.f, 0.f, 0.f), o2 = make_float4(0.f, 0.f, 0.f, 0.f);
    for (int j = 0; j < SEQ; ++j) {
        const float* krow = cols + (size_t)(base + j) * IN_COLS + OFF_C;
        const float2 k1 = *(const float2*)(krow + 256 + (2 * h) * 32 + l * 2), k2 = *(const float2*)(krow + 256 + (2 * h + 1) * 32 + l * 2);
        float s1 = q1.x * k1.x + q1.y * k1.y, s2 = q2.x * k2.x + q2.y * k2.y;
        s1 = g16_sum(s1) * scale; s2 = g16_sum(s2) * scale;
        const float4 v = *(const float4*)(krow + 512 + h * 64 + l * 4);
        { const float mn = fmaxf(m1, s1), f = expf(m1 - mn), e = expf(s1 - mn);
          o1.x = o1.x * f + e * v.x; o1.y = o1.y * f + e * v.y; o1.z = o1.z * f + e * v.z; o1.w = o1.w * f + e * v.w; l1 = l1 * f + e; m1 = mn; }
        { const float mn = fmaxf(m2, s2), f = expf(m2 - mn), e = expf(s2 - mn);
          o2.x = o2.x * f + e * v.x; o2.y = o2.y * f + e * v.y; o2.z = o2.z * f + e * v.z; o2.w = o2.w * f + e * v.w; l2 = l2 * f + e; m2 = mn; }
    }
    const float i1 = 1.0f / l1, i2 = lam / l2;
    float4 o = make_float4(o1.x * i1 - o2.x * i2, o1.y * i1 - o2.y * i2, o1.z * i1 - o2.z * i2, o1.w * i1 - o2.w * i2);
    float ss = o.x * o.x + o.y * o.y + o.z * o.z + o.w * o.w;
    ss = g16_sum(ss);
    const float rs = 1.0f / sqrtf(ss / 64.0f + 1e-5f);
    const float4 g = *(const float4*)(subln + l * 4);
    const float post = 1.0f - lam_init;
    *(float4*)(mix + (size_t)r * DM + 512 + h * 64 + l * 4) = make_float4(o.x * rs * g.x * post, o.y * rs * g.y * post, o.z * rs * g.z * post, o.w * rs * g.w * post);
}

extern "C" void kernel_launch(void* const* d_in, const int* in_sizes, int n_in, void* d_out, int out_size, void* d_ws, size_t ws_size, hipStream_t stream) {
    const float* x = (const float*)d_in[0];
    const float* p = (const float*)d_in[1];
    const float* attn_norm = (const float*)d_in[2];
    const float* w_in = (const float*)d_in[3];
    const float* mla_q_norm = (const float*)d_in[4];
    const float* w_uq = (const float*)d_in[5];
    const float* mla_kv_norm = (const float*)d_in[6];
    const float* w_ukv = (const float*)d_in[7];
    const float* lam_q1 = (const float*)d_in[8];
    const float* lam_k1 = (const float*)d_in[9];
    const float* lam_q2 = (const float*)d_in[10];
    const float* lam_k2 = (const float*)d_in[11];
    const float* diff_subln = (const float*)d_in[12];
    const float* na_rpb = (const float*)d_in[13];
    const float* w_o = (const float*)d_in[14];
    const float* ffn_norm = (const float*)d_in[15];
    const float* w_up = (const float*)d_in[16];
    const float* conv_w = (const float*)d_in[17];
    const float* conv_b = (const float*)d_in[18];
    const float* w_down = (const float*)d_in[19];
    const float* ple_norm = (const float*)d_in[20];
    const float* w_ple_gate = (const float*)d_in[21];
    const float* w_ple_proj = (const float*)d_in[22];
    const float* final_norm = (const float*)d_in[23];
    float* h = (float*)d_out;


    float* ws = (float*)d_ws;
    size_t off = 0;
    auto take = [&](size_t n) { float* r = ws + off; off += (n + 63) & ~(size_t)63; return r; };
    float* lamv = take(64);
    float* tab = take(64);
    float* hn = take((size_t)GR * DM);
    float* cols = take((size_t)GR * IN_COLS);
    float* cqn = take((size_t)GR * 384);
    float* ckvn = take((size_t)GR * 256);
    float* qb = take((size_t)GR * 384);
    float* kvb = take((size_t)GR * 512);
    float* mix = take((size_t)GR * DM);
    float* U = take((size_t)GR * 2 * DFF);
    float* act = take((size_t)GR * DFF);
    float* eb = take((size_t)GR * DM);
    float* gb = take((size_t)GR * DM);
    if (off * 4 > ws_size) { fprintf(stderr, "workspace too small: need %zu have %zu\n", off * 4, ws_size); return; }

    hipMemcpyAsync(h, x, (size_t)MTOK * DM * 4, hipMemcpyDeviceToDevice, stream);
    hipLaunchKernelGGL(k_tab, dim3(1), dim3(64), 0, stream, tab);
    const int nb_att = (4 * GR * 16 + 255) / 256;
    for (int g = 0; g < NGRP; ++g) {
        const int row0 = g * GR;
        float* hg = h + (size_t)row0 * DM;
        for (int i = 0; i < DEPTH; ++i) {
            const float lam_init = (float)(0.8 - 0.6 * std::exp(-0.3 * (double)i));
            hipLaunchKernelGGL(k_scalar_lam, dim3(1), dim3(64), 0, stream, lam_q1 + i * 32, lam_k1 + i * 32, lam_q2 + i * 32, lam_k2 + i * 32, lam_init, lamv);
            hipLaunchKernelGGL(k_rmsnorm, dim3(GR / 4), dim3(256), 0, stream, hg, DM, attn_norm + i * DM, hn, DM, GR, DM, 1e-6f, 1.0f);
            gemm(false, hn, DM, w_in + (size_t)i * DM * IN_COLS, IN_COLS, cols, IN_COLS, GR, IN_COLS, DM, stream);
            hipLaunchKernelGGL(k_rope, dim3((GR * 8 * 32 + 255) / 256), dim3(256), 0, stream, cols, IN_COLS, OFF_A, 8, 64, 64, GR, row0, tab);
            hipLaunchKernelGGL(k_rope, dim3((GR * 16 * 16 + 255) / 256), dim3(256), 0, stream, cols, IN_COLS, OFF_C, 16, 32, 32, GR, row0, tab);
            hipLaunchKernelGGL(k_rope, dim3((GR * 1 * 16 + 255) / 256), dim3(256), 0, stream, cols, IN_COLS, OFF_B + 640, 1, 32, 32, GR, row0, tab);
            hipLaunchKernelGGL(k_rmsnorm, dim3(GR / 4), dim3(256), 0, stream, cols + OFF_B, IN_COLS, mla_q_norm + i * 384, cqn, 384, GR, 384, 1e-6f, 1.0f);
            hipLaunchKernelGGL(k_rmsnorm, dim3(GR / 4), dim3(256), 0, stream, cols + OFF_B + 384, IN_COLS, mla_kv_norm + i * 256, ckvn, 256, GR, 256, 1e-6f, 1.0f);
            gemm(false, cqn, 384, w_uq + (size_t)i * 384 * 384, 384, qb, 384, GR, 384, 384, stream);
            gemm(false, ckvn, 256, w_ukv + (size_t)i * 256 * 512, 512, kvb, 512, GR, 512, 256, stream);
            hipLaunchKernelGGL(k_rope, dim3((GR * 4 * 16 + 255) / 256), dim3(256), 0, stream, qb, 384, 64, 4, 32, 96, GR, row0, tab);
            hipLaunchKernelGGL(k_mix_a, dim3(nb_att), dim3(256), 0, stream, cols, mix, GR);
            hipLaunchKernelGGL(k_mix_b, dim3(nb_att), dim3(256), 0, stream, cols, qb, kvb, mix, GR);
            hipLaunchKernelGGL(k_mix_c2, dim3(nb_att), dim3(256), 0, stream, cols, diff_subln + i * 64, lamv, lam_init, mix, GR);
            hipLaunchKernelGGL(k_mix_d, dim3(nb_att), dim3(256), 0, stream, cols, na_rpb + (size_t)i * 4 * 15 * 31, mix, GR);
            gemm(true, mix, DM, w_o + (size_t)i * DM * DM, DM, hg, DM, GR, DM, DM, stream);
            hipLaunchKernelGGL(k_rmsnorm, dim3(GR / 4), dim3(256), 0, stream, hg, DM, ffn_norm + i * DM, hn, DM, GR, DM, 1e-6f, 1.0f);
            gemm(false, hn, DM, w_up + (size_t)i * DM * 2 * DFF, 2 * DFF, U, 2 * DFF, GR, 2 * DFF, DM, stream);
            hipLaunchKernelGGL(k_conv_gelu, dim3((unsigned)(((size_t)GR * DFF + 255) / 256)), dim3(256), 0, stream, U, conv_w + (size_t)i * 3 * 2 * DFF, conv_b + (size_t)i * 2 * DFF, act, GR);
            gemm(true, act, DFF, w_down + (size_t)i * DFF * DM, DM, hg, DM, GR, DM, DFF, stream);
            gemm(false, p + ((size_t)i * MTOK + row0) * PLE, PLE, w_ple_proj + (size_t)i * PLE * DM, DM, eb, DM, GR, DM, PLE, stream);
            hipLaunchKernelGGL(k_rmsnorm, dim3(GR / 4), dim3(256), 0, stream, hg, DM, ple_norm + i * DM, hn, DM, GR, DM, 1e-6f, 1.0f);
            gemm(false, hn, DM, w_ple_gate + (size_t)i * DM * DM, DM, gb, DM, GR, DM, DM, stream);
            hipLaunchKernelGGL(k_ple, dim3(GR * DM / 256), dim3(256), 0, stream, hg, gb, eb, GR * DM);
        }
        hipLaunchKernelGGL(k_rmsnorm, dim3(GR / 4), dim3(256), 0, stream, hg, DM, final_norm, hn, DM, GR, DM, 1e-6f, 1.0f);
        hipMemcpyAsync(hg, hn, (size_t)GR * DM * 4, hipMemcpyDeviceToDevice, stream);
    }
}
```

```cpp
#include <hip/hip_runtime.h>
#include <cstdio>
#include <cstdint>
#include <cmath>
#define MK_SINGLE 1
namespace pg8 {
__device__ __forceinline__ int lane_now() { int l; asm volatile("v_mbcnt_lo_u32_b32 %0, -1, 0\n\tv_mbcnt_hi_u32_b32 %0, -1, %0" : "=v"(l)); return l; }
#define PG8_LAS __attribute__((address_space(3)))
typedef unsigned short bf16_t;
typedef short bf16x8 __attribute__((ext_vector_type(8)));
typedef float f32x4 __attribute__((ext_vector_type(4)));
typedef unsigned u32x4 __attribute__((ext_vector_type(4)));
constexpr int BM = 256, BK = 64, HALF = 128, HTB = HALF * BK * 2  , STAGE_BYTES = 8 * HTB, NXCD = 8, WGM = 8;

__host__ __device__ __forceinline__ int lds_byte(int r, int c) { const int st = (r >> 4) * 2 + (c >> 5), rr = r & 15, cc = c & 31, ob = rr * 64 + cc * 2; return st * 1024 + (ob ^ (((ob >> 9) & 1) << 5)); }
__host__ __device__ __forceinline__ void stage_rc(int b, int& R, int& C) { const int st = b / 1024, sb = b % 1024, swz = sb ^ (((sb >> 9) & 1) << 5); R = (st >> 1) * 16 + swz / 64; C = (st & 1) * 32 + (swz % 64) / 2; }
__host__ __device__ __forceinline__ int perm32(int rho) { const int n = rho >> 4, i = rho & 15; return 8 * (i >> 2) + 4 * n + (i & 3); }

struct Unit { int pm, pn; };
struct Gemm { const bf16_t* A; const bf16_t* Bt; int M, N, K; };

struct StaticOrder {
    int nM, nN, nwg, G, c;
    __host__ __device__ void init(int M, int N, int G_, int c_) { nM = M / BM; nN = N / BM; nwg = nM * nN; G = G_; c = c_; }
    __host__ __device__ bool next(int i, Unit& u) const {
        const long L = (long)i * G + c; if (L >= nwg) return false;
        int wgid = (int)L; { const int q = nwg / NXCD, r = nwg % NXCD, xcd = wgid % NXCD, off = wgid / NXCD; wgid = (xcd < r ? xcd * (q + 1) : r * (q + 1) + (xcd - r) * q) + off; }
        const int nig = WGM * nN, gid = wgid / nig, fm = gid * WGM, gsz = (nM - fm) < WGM ? (nM - fm) : WGM;
        u.pm = fm + ((wgid % nig) % gsz); u.pn = (wgid % nig) / gsz; return true;
    }
    __device__ __forceinline__ void a_ready(const Unit&) const {}
    __device__ __forceinline__ void done(const Unit&) const {}
};
__device__ __forceinline__ unsigned cvt_pk_bf16(float lo, float hi) { unsigned r; asm volatile("v_cvt_pk_bf16_f32 %0, %1, %2" : "=v"(r) : "v"(lo), "v"(hi)); return r; }
typedef float f32x2 __attribute__((ext_vector_type(2)));
template <class Epi, class Sched, bool ALIGN_EPI = false, bool SP2 = false>
__device__ __forceinline__ void gemm_phase(PG8_LAS unsigned char* lds, const Gemm g, const Sched& S, const Epi& E, int wave_id) {
    int tid_ = (wave_id << 6) | lane_now();
    const int tid = tid_, wid = __builtin_amdgcn_readfirstlane(tid >> 6), lane = tid & 63, wr = wid >> 2, wc = wid & 3, fr = lane & 15, fq = lane >> 4;
    int K_ = __builtin_amdgcn_readfirstlane(g.K); asm volatile("" : "+s"(K_));
    const int K = K_, nt = K / BK;
    unsigned voffA[2], voffB[2];
#pragma unroll
    for (int i = 0; i < 2; ++i) { int R, C; stage_rc(tid * 16 + i * 8192, R, C); const int Rb = Epi::PERM ? ((R & ~31) + perm32(R & 31)) : R;
        const int Ra = Epi::AROWPERM ? ((R & ~63) + (((R & 15) << 2) | ((R >> 4) & 3))) : R;
        voffA[i] = (unsigned)(Ra * K + C) * 2u; voffB[i] = (unsigned)(Rb * K + C) * 2u; }
    const size_t kstep = (size_t)(BK * 2);
    const size_t hstep = (size_t)HALF * K * 2;
    const size_t tstep = 2 * hstep;
    const unsigned ldsw = (unsigned)wid * 1024u;
    const int aoff = lds_byte(wr * 64 + fr, fq * 8), boff = lds_byte(wc * 32 + fr, fq * 8);
#define PG8_SA(b, h) (((b) * 2 + (h)) * HTB)
#define PG8_SB(b, h) ((4 + (b) * 2 + (h)) * HTB)
#define PG8_STAGE(bufoff, gbase, voff) do { _Pragma("unroll") for (int _i = 0; _i < 2; ++_i) \
        __builtin_amdgcn_global_load_lds((const unsigned*)((const char*)(gbase) + (voff)[_i]), (PG8_LAS unsigned*)(lds + (bufoff) + ldsw + _i * 8192), 16, 0, 0); } while (0)
#define PG8_LDA(dst, b, h) do { _Pragma("unroll") for (int m = 0; m < 4; ++m) _Pragma("unroll") for (int k = 0; k < 2; ++k) dst[m][k] = *(const PG8_LAS bf16x8*)(lds + PG8_SA(b, h) + aoff + m * 2048 + k * 1024); } while (0)
#define PG8_LDB(dst, b, h) do { _Pragma("unroll") for (int n = 0; n < 2; ++n) _Pragma("unroll") for (int k = 0; k < 2; ++k) dst[n][k] = *(const PG8_LAS bf16x8*)(lds + PG8_SB(b, h) + boff + n * 2048 + k * 1024); } while (0)
#define PG8_MMA(ai, bj, At, Bt) do { __builtin_amdgcn_s_setprio(1); _Pragma("unroll") for (int m = 0; m < 4; ++m) _Pragma("unroll") for (int n = 0; n < 2; ++n) _Pragma("unroll") for (int k = 0; k < 2; ++k) \
        acc[ai][bj][m][n] = __builtin_amdgcn_mfma_f32_16x16x32_bf16(Bt[n][k], At[m][k], acc[ai][bj][m][n], 0, 0, 0); __builtin_amdgcn_s_setprio(0); } while (0)
#define PG8_WAIT_V(n) asm volatile("s_waitcnt vmcnt(" #n ")" ::: "memory")
#define PG8_WAIT_L(n) asm volatile("s_waitcnt lgkmcnt(" #n ")" ::: "memory")
#define PG8_BAR __builtin_amdgcn_s_barrier()
#define PG8_SCHED __builtin_amdgcn_sched_barrier(0)
    Unit cur, nxt; int ui = 0;
    if (!S.next(0, cur)) return;
    typename Epi::Carry cy; if constexpr (Epi::STAGED) { cy.pm = -1; E.stage(cur, 0, wid, lane); }
    f32x4 acc[2][2][4][2];
#pragma unroll
    for (int a = 0; a < 2; ++a)
#pragma unroll
        for (int b = 0; b < 2; ++b)
#pragma unroll
            for (int m = 0; m < 4; ++m)
#pragma unroll
                for (int n = 0; n < 2; ++n) acc[a][b][m][n] = (f32x4){0.f, 0.f, 0.f, 0.f};
    bf16x8 At[4][2], B0[2][2], B1[2][2];
    const char* cA = (const char*)g.A + (size_t)cur.pm * tstep; const char* cB = (const char*)g.Bt + (size_t)cur.pn * tstep;
    S.a_ready(cur);
    if constexpr (SP2) {
        PG8_STAGE(PG8_SB(0, 0), cB, voffB); PG8_STAGE(PG8_SB(0, 1), cB + hstep, voffB); PG8_STAGE(PG8_SA(0, 0), cA, voffA); PG8_STAGE(PG8_SA(0, 1), cA + hstep, voffA);
        if (wr == 1) PG8_BAR;
        PG8_WAIT_V(2); PG8_BAR;
        PG8_STAGE(PG8_SB(1, 0), cB + kstep, voffB); PG8_STAGE(PG8_SA(1, 0), cA + kstep, voffA); PG8_STAGE(PG8_SB(1, 1), cB + hstep + kstep, voffB);
        PG8_WAIT_V(6); PG8_BAR;
    } else {
        PG8_STAGE(PG8_SB(0, 0), cB, voffB); PG8_STAGE(PG8_SA(0, 0), cA, voffA); PG8_STAGE(PG8_SB(0, 1), cB + hstep, voffB); PG8_STAGE(PG8_SA(0, 1), cA + hstep, voffA);
        if (wr == 1) PG8_BAR;
        PG8_WAIT_V(4); PG8_BAR;
        PG8_STAGE(PG8_SB(1, 0), cB + kstep, voffB); PG8_STAGE(PG8_SA(1, 0), cA + kstep, voffA); PG8_STAGE(PG8_SB(1, 1), cB + hstep + kstep, voffB);
        PG8_WAIT_V(6); PG8_BAR;
    }
    for (;;) {
        const bool has_next = S.next(ui + 1, nxt);
        const char* nA = has_next ? (const char*)g.A + (size_t)nxt.pm * tstep : cA; const char* nB = has_next ? (const char*)g.Bt + (size_t)nxt.pn * tstep : cB;
        for (int t = 0; t < nt; t += 2) {
            const bool last = (t == nt - 2);
            const char* a1 = cA + (size_t)(t + 1) * kstep;
            const char* a2 = last ? nA : cA + (size_t)(t + 2) * kstep; const char* b2 = last ? nB : cB + (size_t)(t + 2) * kstep;
            const char* a3 = a2 + kstep; const char* b3 = b2 + kstep;
            if (last && has_next) S.a_ready(nxt);
            if constexpr (SP2) {
            const bool tail = last && !has_next;
            PG8_LDB(B0, 0, 0); PG8_LDB(B1, 0, 1); PG8_SCHED; PG8_LDA(At, 0, 0); PG8_STAGE(PG8_SA(1, 1), a1 + hstep, voffA);
            PG8_WAIT_V(8); PG8_WAIT_L(0); PG8_BAR; PG8_MMA(0, 0, At, B0); PG8_MMA(0, 1, At, B1); PG8_BAR; PG8_SCHED;
            PG8_LDA(At, 0, 1);
            if (!tail) { PG8_STAGE(PG8_SB(0, 0), b2, voffB); PG8_STAGE(PG8_SB(0, 1), b2 + hstep, voffB); PG8_STAGE(PG8_SA(0, 0), a2, voffA); PG8_WAIT_V(8); } else { PG8_WAIT_V(2); }
            PG8_WAIT_L(0); PG8_BAR; PG8_MMA(1, 0, At, B0); PG8_MMA(1, 1, At, B1); PG8_BAR; PG8_SCHED;
            PG8_LDB(B0, 1, 0); PG8_LDB(B1, 1, 1); PG8_SCHED; PG8_LDA(At, 1, 0);
            if (!tail) { PG8_STAGE(PG8_SA(0, 1), a2 + hstep, voffA); PG8_WAIT_V(8); } else { PG8_WAIT_V(0); }
            PG8_WAIT_L(0); PG8_BAR; PG8_MMA(0, 0, At, B0); PG8_MMA(0, 1, At, B1); PG8_BAR; PG8_SCHED;
            PG8_LDA(At, 1, 1);
            if (!tail) { PG8_STAGE(PG8_SB(1, 0), b3, voffB); PG8_STAGE(PG8_SB(1, 1), b3 + hstep, voffB); PG8_STAGE(PG8_SA(1, 0), a3, voffA); PG8_WAIT_V(8); }
            PG8_WAIT_L(0); PG8_BAR; PG8_MMA(1, 0, At, B0); PG8_MMA(1, 1, At, B1); PG8_BAR; PG8_SCHED;
            } else {
            PG8_LDB(B0, 0, 0); PG8_SCHED; PG8_LDA(At, 0, 0); PG8_STAGE(PG8_SA(1, 1), a1 + hstep, voffA);
            PG8_WAIT_L(8); PG8_BAR; PG8_WAIT_L(0); PG8_MMA(0, 0, At, B0); PG8_BAR; PG8_SCHED;
            PG8_LDB(B1, 0, 1); PG8_STAGE(PG8_SB(0, 0), b2, voffB);
            PG8_BAR; PG8_WAIT_L(0); PG8_MMA(0, 1, At, B1); PG8_BAR;
            PG8_LDA(At, 0, 1); PG8_STAGE(PG8_SA(0, 0), a2, voffA);
            PG8_BAR; PG8_WAIT_L(0); PG8_MMA(1, 0, At, B0); PG8_BAR; PG8_SCHED;
            PG8_STAGE(PG8_SB(0, 1), b2 + hstep, voffB);
            PG8_WAIT_V(6); PG8_BAR; PG8_MMA(1, 1, At, B1); PG8_BAR;
            PG8_LDB(B0, 1, 0); PG8_SCHED; PG8_LDA(At, 1, 0); PG8_STAGE(PG8_SA(0, 1), a2 + hstep, voffA);
            PG8_WAIT_L(8); PG8_BAR; PG8_WAIT_L(0); PG8_MMA(0, 0, At, B0); PG8_BAR; PG8_SCHED;
            PG8_LDB(B1, 1, 1); PG8_STAGE(PG8_SB(1, 0), b3, voffB);
            PG8_BAR; PG8_WAIT_L(0); PG8_MMA(0, 1, At, B1); PG8_BAR;
            PG8_LDA(At, 1, 1); PG8_STAGE(PG8_SA(1, 0), a3, voffA);
            PG8_BAR; PG8_WAIT_L(0); PG8_MMA(1, 0, At, B0); PG8_BAR; PG8_SCHED;
            PG8_STAGE(PG8_SB(1, 1), b3 + hstep, voffB);
            PG8_WAIT_V(6); PG8_BAR; PG8_MMA(1, 1, At, B1); PG8_BAR;
            }
        }
        if constexpr (ALIGN_EPI) { if (wr == 0) PG8_BAR; }
        if constexpr (!Epi::AFTER_DRAIN) { if constexpr (Epi::STAGED) E(acc, cur, wr, wc, fr, fq, cy, ui & 1); else E(acc, cur, wr, wc, fr, fq); S.done(cur); }
        if (!has_next) break;
#pragma unroll
        for (int a = 0; a < 2; ++a)
#pragma unroll
            for (int b = 0; b < 2; ++b)
#pragma unroll
                for (int m = 0; m < 4; ++m)
#pragma unroll
                    for (int n = 0; n < 2; ++n) acc[a][b][m][n] = (f32x4){0.f, 0.f, 0.f, 0.f};
        cur = nxt; cA = nA; cB = nB; ++ui;
        if constexpr (Epi::STAGED) E.stage(cur, ui & 1, wid, lane_now());
        if constexpr (ALIGN_EPI) { if (wr == 1) PG8_BAR; }
    }
    PG8_WAIT_V(0);
    if constexpr (!ALIGN_EPI) { if (wr == 0) PG8_BAR; }
    PG8_BAR;
    if constexpr (Epi::AFTER_DRAIN) { E.fused(acc, cur, wr, wc, fr, fq, lds, wid, lane); S.done(cur); }
#undef PG8_SA
#undef PG8_SB
#undef PG8_STAGE
#undef PG8_LDA
#undef PG8_LDB
#undef PG8_MMA
#undef PG8_WAIT_V
#undef PG8_WAIT_L
#undef PG8_BAR
#undef PG8_SCHED
}
}
#define GAS __attribute__((address_space(1)))
#define LAS __attribute__((address_space(3)))
typedef unsigned short bf16;
typedef unsigned v4u __attribute__((ext_vector_type(4)));
typedef float f32x4 __attribute__((ext_vector_type(4)));
typedef short bf16x8 __attribute__((ext_vector_type(8)));
typedef GAS unsigned gu32;
typedef GAS unsigned long long gu64;
#define RLX_AGENT __ATOMIC_RELAXED, __HIP_MEMORY_SCOPE_AGENT
#define LDS_WAIT() asm volatile("s_waitcnt lgkmcnt(0)" ::: "memory")
#define VM_WAIT() asm volatile("s_waitcnt vmcnt(0)" ::: "memory")
__device__ __forceinline__ unsigned long long rt() { return __builtin_amdgcn_s_memrealtime(); }
__device__ __forceinline__ unsigned f2bf(float f) { unsigned u = __builtin_bit_cast(unsigned, f); return (u + 0x7fffu + ((u >> 16) & 1u)) >> 16; }
__device__ __forceinline__ unsigned pk2(float lo, float hi) { return f2bf(lo) | (f2bf(hi) << 16); }

#define XB_TMO      128
#define XB_XCNT(j)  (256  + 64 * (j))
#define XB_XSUB(j)  (1280 + 64 * (j))
#define XB_XGEN(j)  (2304 + 64 * (j))
#define XB_TOP      3328
#define XB_TOPGEN   3392
#define XCD_BAR_WORDS 3456
#define XB_SPIN_CAP (1u << 18)
#define XB_CW_BAR 4096
#define XB_CW_GRP 8192
#define XB_CW_XCC 12288

__device__ __forceinline__ unsigned xb_ld(unsigned* p)              { return __hip_atomic_load(p, __ATOMIC_RELAXED, __HIP_MEMORY_SCOPE_AGENT); }
__device__ __forceinline__ unsigned xb_add(unsigned* p, unsigned v) { return __hip_atomic_fetch_add(p, v, __ATOMIC_RELAXED, __HIP_MEMORY_SCOPE_AGENT); }
__device__ __forceinline__ unsigned xb_xcc_id() { return (unsigned)__builtin_amdgcn_s_getreg((3 << 11) | 20) & 0xFu; }
#define XB_SPIN(cond, bar) do { unsigned _sp = 0; while (cond) { __builtin_amdgcn_s_sleep(1); \
    if ((++_sp & 255u) == 0u) { if (xb_ld(&(bar)[XB_TMO])) break; if (_sp > XB_SPIN_CAP) { atomicAdd(&(bar)[XB_TMO], 1u); break; } } } } while (0)

struct XcdBarrier {
    int wave;
    unsigned* bar; unsigned x;
    volatile LAS unsigned* st;
};

__device__ __forceinline__ XcdBarrier xcd_barrier_post(unsigned* bar, volatile LAS unsigned* st, int wave) {
    XcdBarrier b; b.wave = wave; b.bar = bar; b.x = xb_xcc_id(); b.st = st;
    if (wave == 0 && pg8::lane_now() == 0) { __hip_atomic_store(bar + (XB_CW_XCC - XB_CW_BAR) + blockIdx.x, b.x + 1u, __ATOMIC_RELAXED, __HIP_MEMORY_SCOPE_AGENT); (void)xb_add(&bar[XB_XCNT(b.x)], 1u); }
    return b;
}
__device__ __forceinline__ void xcd_barrier_complete(unsigned* bar, unsigned x, unsigned& nloc, unsigned& nx) {
    const unsigned G = gridDim.x * gridDim.y * gridDim.z;
    unsigned sum, cnt, mine, sp = 0u;
    for (;;) {
        sum = 0u; cnt = 0u; mine = 0u;
        unsigned cv[16];
        { unsigned* cb = bar + XB_XCNT(0);
          asm volatile("global_load_dword %0, %16, off sc1\n\tglobal_load_dword %1, %16, off offset:256 sc1\n\tglobal_load_dword %2, %16, off offset:512 sc1\n\tglobal_load_dword %3, %16, off offset:768 sc1\n\t"
                       "global_load_dword %4, %16, off offset:1024 sc1\n\tglobal_load_dword %5, %16, off offset:1280 sc1\n\tglobal_load_dword %6, %16, off offset:1536 sc1\n\tglobal_load_dword %7, %16, off offset:1792 sc1\n\t"
                       "global_load_dword %8, %16, off offset:2048 sc1\n\tglobal_load_dword %9, %16, off offset:2304 sc1\n\tglobal_load_dword %10, %16, off offset:2560 sc1\n\tglobal_load_dword %11, %16, off offset:2816 sc1\n\t"
                       "global_load_dword %12, %16, off offset:3072 sc1\n\tglobal_load_dword %13, %16, off offset:3328 sc1\n\tglobal_load_dword %14, %16, off offset:3584 sc1\n\tglobal_load_dword %15, %16, off offset:3840 sc1\n\t"
                       "s_waitcnt vmcnt(0)"
                       : "=&v"(cv[0]), "=&v"(cv[1]), "=&v"(cv[2]), "=&v"(cv[3]), "=&v"(cv[4]), "=&v"(cv[5]), "=&v"(cv[6]), "=&v"(cv[7]),
                         "=&v"(cv[8]), "=&v"(cv[9]), "=&v"(cv[10]), "=&v"(cv[11]), "=&v"(cv[12]), "=&v"(cv[13]), "=&v"(cv[14]), "=&v"(cv[15]) : "v"(cb) : "memory"); }
#pragma unroll
        for (unsigned j = 0; j < 16; ++j) { const unsigned c = cv[j]; sum += c; cnt += (c > 0u) ? 1u : 0u; mine = (j == x) ? c : mine; }
        if (sum == G) break;
        __builtin_amdgcn_s_sleep(1);
        if ((++sp & 255u) == 0u) { if (xb_ld(&bar[XB_TMO])) break; if (sp > XB_SPIN_CAP) { atomicAdd(&bar[XB_TMO], 1u); break; } }
    }
    nloc = mine > 0u ? mine : 1u; nx = cnt > 0u ? cnt : 1u;
}

__device__ __forceinline__ void xcd_barrier(const XcdBarrier& b) {
    asm volatile("s_waitcnt vmcnt(0)" ::: "memory");
    __syncthreads();
    if (b.wave == 0 && pg8::lane_now() == 0) {
        unsigned* bar = b.bar; asm volatile("" : "+s"(bar));
        __builtin_amdgcn_s_waitcnt(0);
        unsigned nloc = b.st[0], nx = b.st[1];
        if (nloc == 0u) { xcd_barrier_complete(bar, b.x, nloc, nx); b.st[0] = nloc; b.st[1] = nx; }
        const unsigned old = xb_add(&bar[XB_XSUB(b.x)], 1u);
        const unsigned gen = old / nloc;
        if (old + 1u == (gen + 1u) * nloc) {
            __builtin_amdgcn_fence(__ATOMIC_RELEASE, "agent");
            asm volatile("s_waitcnt vmcnt(0)" ::: "memory");
            const unsigned og = xb_add(&bar[XB_TOP], 1u);
            const unsigned tg = og / nx;
            if (og + 1u == (tg + 1u) * nx) xb_add(&bar[XB_TOPGEN], 1u);
            else XB_SPIN(xb_ld(&bar[XB_TOPGEN]) == tg, bar);
            __builtin_amdgcn_fence(__ATOMIC_ACQUIRE, "agent");
            xb_add(&bar[XB_XGEN(b.x)], 1u);
            asm volatile("s_waitcnt vmcnt(0)" ::: "memory");
        } else {
            XB_SPIN(xb_ld(&bar[XB_XGEN(b.x)]) == gen, bar);
            __builtin_amdgcn_fence(__ATOMIC_ACQUIRE, "agent");
            asm volatile("s_waitcnt vmcnt(0)" ::: "memory");
        }
    }
    __syncthreads();
}

__device__ __forceinline__ void grp_barrier(const XcdBarrier& b, unsigned x, unsigned nloc, unsigned publish, unsigned need, bool release) {
    asm volatile("s_waitcnt vmcnt(0)" ::: "memory");
    __syncthreads();
    if (b.wave == 0 && pg8::lane_now() == 0) {
        unsigned* bar = b.bar; asm volatile("" : "+s"(bar));
        __builtin_amdgcn_s_waitcnt(0);
        asm volatile("buffer_inv sc1" ::: "memory");
        unsigned* sub = bar + (XB_CW_GRP - XB_CW_BAR) + 64u * x; unsigned* genw = sub + 1024; unsigned* prog = bar + (XB_CW_GRP - XB_CW_BAR) + 2048;
        const unsigned old = xb_add(sub, 1u);
        const unsigned gen = old / nloc;
        if (old + 1u == (gen + 1u) * nloc) {
            if (release) { __builtin_amdgcn_fence(__ATOMIC_RELEASE, "agent"); asm volatile("s_waitcnt vmcnt(0)" ::: "memory"); }
            __hip_atomic_store(prog + 64u * x, publish, __ATOMIC_RELAXED, __HIP_MEMORY_SCOPE_AGENT);
            if (need != 0u) {
                unsigned sp_ = 0u;
                for (;;) {
                    unsigned pv[8];
                    asm volatile("global_load_dword %0, %8, off sc1\n\tglobal_load_dword %1, %8, off offset:256 sc1\n\tglobal_load_dword %2, %8, off offset:512 sc1\n\tglobal_load_dword %3, %8, off offset:768 sc1\n\t"
                                 "global_load_dword %4, %8, off offset:1024 sc1\n\tglobal_load_dword %5, %8, off offset:1280 sc1\n\tglobal_load_dword %6, %8, off offset:1536 sc1\n\tglobal_load_dword %7, %8, off offset:1792 sc1\n\t"
                                 "s_waitcnt vmcnt(0)"
                                 : "=&v"(pv[0]), "=&v"(pv[1]), "=&v"(pv[2]), "=&v"(pv[3]), "=&v"(pv[4]), "=&v"(pv[5]), "=&v"(pv[6]), "=&v"(pv[7]) : "v"(prog) : "memory");
                    unsigned mn = pv[0];
#pragma unroll
                    for (unsigned g = 1; g < 8u; ++g) mn = pv[g] < mn ? pv[g] : mn;
                    if (mn >= need) break;
                    __builtin_amdgcn_s_sleep(1);
                    if ((++sp_ & 255u) == 0u) { if (xb_ld(&bar[XB_TMO])) break; if (sp_ > XB_SPIN_CAP) { atomicAdd(&bar[XB_TMO], 1u); break; } }
                }
            }
            xb_add(genw, 1u);
        } else XB_SPIN(xb_ld(genw) == gen, bar);
        asm volatile("s_waitcnt vmcnt(0)" ::: "memory");
    }
    __syncthreads();
}
__device__ __forceinline__ void grp_arrive(const XcdBarrier& b, unsigned x, unsigned slot) {
    asm volatile("s_waitcnt vmcnt(0)" ::: "memory");
    __syncthreads();
    if (b.wave == 0 && pg8::lane_now() == 0) {
        unsigned* bar = b.bar; asm volatile("" : "+s"(bar));
        __builtin_amdgcn_s_waitcnt(0);
        (void)xb_add(bar + (XB_CW_GRP - XB_CW_BAR) + 3072u + 512u * slot + 64u * x, 1u);
    }
}
__device__ __forceinline__ void grp_wait(const XcdBarrier& b, unsigned x, unsigned slot, unsigned target) {
    if (b.wave == 0 && pg8::lane_now() == 0) {
        unsigned* bar = b.bar; asm volatile("" : "+s"(bar));
        unsigned* w = bar + (XB_CW_GRP - XB_CW_BAR) + 3072u + 512u * slot + 64u * x;
        XB_SPIN(xb_ld(w) < target, bar);
        asm volatile("buffer_inv sc1\n\ts_waitcnt vmcnt(0)" ::: "memory");
    }
    __syncthreads();
}
__device__ __forceinline__ unsigned grp_mode(unsigned* bar, int G) {
    const int ln = pg8::lane_now();
    bool ok = (G == 256);
    if (ok) {
        const unsigned* xa = bar + (XB_CW_XCC - XB_CW_BAR) + 4 * ln; const unsigned* xr = bar + (XB_CW_XCC - XB_CW_BAR) + 4 * (ln & 1);
        v4u a, r;
        asm volatile("global_load_dwordx4 %0, %2, off sc1\n\tglobal_load_dwordx4 %1, %3, off sc1\n\ts_waitcnt vmcnt(0)" : "=&v"(a), "=&v"(r) : "v"(xa), "v"(xr) : "memory");
        ok = (a.x == r.x) && (a.y == r.y) && (a.z == r.z) && (a.w == r.w) && (a.x != 0u) && (a.y != 0u) && (a.z != 0u) && (a.w != 0u);
    }
    return (__ballot(ok) == ~0ull) ? 1u : 0u;
}

constexpr int DMODEL = 1024, NBATCH = 8, SEQ = 2048, DEPTH = 4, M = NBATCH * SEQ;
constexpr int IN_COLS = 2976, N1 = 3072, DFF = 2816, NUP = 2 * DFF, PLE = 256;
constexpr int OFF_A = 0, OFF_B = 768, OFF_C = 1440, OFF_D = 2208;
constexpr float LOG2E = 1.4426950408889634f;
constexpr float SC_A = 0.125f * LOG2E, SC_C = 0.17677669529663687f * LOG2E, SC_D = 0.125f * LOG2E, SC_B = 0.10206207261596575f * LOG2E;
constexpr float NORM_EPS = 1e-6f;
constexpr int NWAVES = 8, NTHREADS = 512;
constexpr int PH_PER_LAYER = 9, N_PHASES = DEPTH * PH_PER_LAYER + 2;

#ifndef MK_SINGLE
#define MK_SINGLE 1
#endif

constexpr size_t KiB = 1024, MiB = 1u << 20;
constexpr size_t WS_CTL = 0, CTL_ZERO_BYTES = 1 * MiB;
constexpr size_t WS_TAB64 = 1 * MiB, WS_TAB32 = WS_TAB64 + 512 * KiB;
constexpr size_t WS_SSQA = 2 * MiB, WS_SSQB = 3 * MiB, WS_SSQC = 4 * MiB, WS_SSQCQ = 5 * MiB, WS_SSQCKV = 5 * MiB + 512 * KiB;
constexpr size_t WS_HALO = 6 * MiB;
constexpr size_t WS_W = 12 * MiB, W_STRIDE = 28 * MiB;
constexpr size_t W_1T = 0, W_UPT = 6 * MiB, W_DNT = 17 * MiB, W_OT = 22 * MiB + 512 * KiB, W_GT = 24 * MiB + 512 * KiB, W_PPT = 26 * MiB + 512 * KiB, W_UQT = 27 * MiB, W_UKVT = 27 * MiB + 384 * KiB;
constexpr size_t WS_HBA = 124 * MiB, WS_HBB = 156 * MiB, WS_PB = 188 * MiB, WS_X = 196 * MiB, WS_END = 328 * MiB;
constexpr size_t X_QO = WS_X, X_KA = WS_X + 32 * MiB, X_VA = WS_X + 40 * MiB, X_KC = WS_X + 48 * MiB, X_VC = WS_X + 56 * MiB, X_KD = WS_X + 64 * MiB, X_VD = WS_X + 72 * MiB;
constexpr size_t X_CQ = WS_X + 80 * MiB, X_CKV = WS_X + 92 * MiB, X_QB = WS_X + 100 * MiB, X_KB = WS_X + 112 * MiB, X_VB = WS_X + 124 * MiB;
constexpr size_t WS_ACT = WS_X + 32 * MiB, X_ESC = X_QO;
static_assert(W_UKVT + 512 * 256 * 2 <= W_STRIDE && WS_W + DEPTH * W_STRIDE <= WS_HBA && X_VB + (size_t)M * 256 * 2 <= WS_END && WS_ACT + (size_t)M * DFF * 2 <= WS_END && WS_HALO + (size_t)64 * 4 * NUP * 4 <= WS_W, "d_ws map");
constexpr int CW_BAR = 4096;
constexpr int CW_GRP = 8192, CW_XCC = 12288;

constexpr int RING_BYTES = 131072, LDSCTL_OFF = RING_BYTES, MISC_OFF = LDSCTL_OFF + 320, XL_OFF = RING_BYTES + 512, CWL_OFF = 147456, RSL_OFF = 155648, LDS_BYTES = 159744;

typedef float f32x2v __attribute__((ext_vector_type(2)));
typedef float f32x16 __attribute__((ext_vector_type(16)));
typedef unsigned u32x2v __attribute__((ext_vector_type(2)));
using pg8::cvt_pk_bf16;

__device__ __forceinline__ float bf2f(unsigned short x) { return __uint_as_float((unsigned)x << 16); }
__device__ __forceinline__ float bflo(unsigned w) { return __uint_as_float(w << 16); }
__device__ __forceinline__ float bfhi(unsigned w) { return __uint_as_float(w & 0xffff0000u); }
template <int X> __device__ __forceinline__ float swz_xor(float v) { return __int_as_float(__builtin_amdgcn_ds_swizzle(__float_as_int(v), (X << 10) | 0x1f)); }
__device__ __forceinline__ float wave_sum(float v) {
    v += swz_xor<1>(v); v += swz_xor<2>(v); v += swz_xor<4>(v); v += swz_xor<8>(v); v += swz_xor<16>(v);
    auto b = __builtin_amdgcn_permlane32_swap(__float_as_uint(v), __float_as_uint(v), false, false); return __uint_as_float(b[0]) + __uint_as_float(b[1]);
}
__device__ __forceinline__ float g16_sum(float v) { v += swz_xor<1>(v); v += swz_xor<2>(v); v += swz_xor<4>(v); v += swz_xor<8>(v); return v; }
__device__ __forceinline__ float fast_rcp(float x) { return __builtin_amdgcn_rcpf(x); }
__device__ __forceinline__ float fast_exp2(float x) { return __builtin_amdgcn_exp2f(x); }

__device__ __forceinline__ void sincos_acc(float ang, float& s, float& c) {
    float K2PI = 0.636619772367581343f, P1 = 1.5703125f, P2 = 4.837512969970703125e-4f, P3 = 7.54978995489188216e-8f;
    float S1 = -1.9515295891e-4f, S2 = 8.3321608736e-3f, S3 = -1.6666654611e-1f, C1 = 2.443315711809948e-5f, C2 = -1.388731625493765e-3f, C3 = 4.166664568298827e-2f;
    asm volatile("" : "+s"(K2PI), "+s"(P1), "+s"(P2), "+s"(P3), "+s"(S1), "+s"(S2), "+s"(S3), "+s"(C1), "+s"(C2), "+s"(C3));
    const float k = rintf(ang * K2PI);
    float r = fmaf(-k, P1, ang);
    r = fmaf(-k, P2, r);
    r = fmaf(-k, P3, r);
    const int q = ((int)k) & 3;
    const float r2 = r * r;
    const float sp = fmaf(r * r2, fmaf(r2, fmaf(r2, S1, S2), S3), r);
    const float cp = fmaf(r2 * r2, fmaf(r2, fmaf(r2, C1, C2), C3), fmaf(r2, -0.5f, 1.0f));
    float sv, cv;
    if (q == 0) { sv = sp; cv = cp; } else if (q == 1) { sv = cp; cv = -sp; } else if (q == 2) { sv = -sp; cv = -cp; } else { sv = -cp; cv = sp; }
    s = sv; c = cv;
}

__device__ const float ROPE_INV[48] = {0x1.0000000000000p+0f, 0x1.7ff2220000000p-1f, 0x1.1feb340000000p-1f, 0x1.afd1360000000p-2f, 0x1.43d1360000000p-2f, 0x1.e5a8480000000p-3f, 0x1.6c310e0000000p-3f, 0x1.111aee0000000p-3f, 0x1.99999a0000000p-4f, 0x1.33281c0000000p-4f, 0x1.ccab860000000p-5f, 0x1.59742a0000000p-5f, 0x1.030dc40000000p-5f, 0x1.8486a00000000p-6f, 0x1.235a720000000p-6f, 0x1.b4f7e20000000p-7f, 0x1.47ae140000000p-7f, 0x1.eb73600000000p-8f, 0x1.7089380000000p-8f, 0x1.145cee0000000p-8f, 0x1.9e7c6e0000000p-9f, 0x1.36d21a0000000p-9f, 0x1.d22a500000000p-10f, 0x1.5d931c0000000p-10f, 0x1.0624de0000000p-10f, 0x1.8929180000000p-11f, 0x1.26d42c0000000p-11f, 0x1.ba2e4c0000000p-12f, 0x1.4b96be0000000p-12f, 0x1.f150280000000p-13f, 0x1.74eea60000000p-13f, 0x1.17a8e40000000p-13f, 0x1.0000000000000p+0f, 0x1.1feb340000000p-1f, 0x1.43d1360000000p-2f, 0x1.6c310e0000000p-3f, 0x1.99999a0000000p-4f, 0x1.ccab860000000p-5f, 0x1.030dc40000000p-5f, 0x1.235a720000000p-6f, 0x1.47ae140000000p-7f, 0x1.7089380000000p-8f, 0x1.9e7c6e0000000p-9f, 0x1.d22a500000000p-10f, 0x1.0624de0000000p-10f, 0x1.26d42c0000000p-11f, 0x1.4b96be0000000p-12f, 0x1.74eea60000000p-13f};

struct Args {
    const float* in[24]; float* out; unsigned char* ws; int ph_lo, ph_hi;
};
struct ArgView {
    const __attribute__((address_space(4))) unsigned char* kp;
    __device__ __forceinline__ const float* in(int i) const { return *(const float* const __attribute__((address_space(4)))*)(kp + 8 * i); }
    __device__ __forceinline__ float* out() const { return *(float* const __attribute__((address_space(4)))*)(kp + 8 * 24); }
};
enum { I_X = 0, I_P, I_ATTN_NORM, I_W_IN, I_QNORM, I_W_UQ, I_KVNORM, I_W_UKV, I_LQ1, I_LK1, I_LQ2, I_LK2, I_SUBLN, I_RPB, I_W_O, I_FFN_NORM, I_W_UP, I_CONV_W, I_CONV_B, I_W_DOWN, I_PLE_NORM, I_W_G, I_W_PP, I_FINAL };

enum { MAP_ID = 0, MAP_IN, MAP_UQ, MAP_UKV, MAP_UP };
__device__ __forceinline__ int map_col(int mt, int n) {
    if (mt == MAP_ID) return n;
    if (mt == MAP_UP) { const int t = n >> 8, c = n & 255; return c < 128 ? t * 128 + c : DFF + t * 128 + (c - 128); }
    if (mt == MAP_UKV) { const int c = n & 255, hh = c >> 6, d = c & 63; return hh * 128 + d + (n >= 256 ? 64 : 0); }
    if (mt == MAP_UQ) { if (n >= 384) return -1; const int hh = n / 96, w = n % 96; if (w < 64) return hh * 96 + w; const int q = w - 64; return hh * 96 + 64 + (q >> 1) + 16 * (q & 1); }
    const int t = n >> 8, c = n & 255;
    switch (t) {
        case 0: case 1: { const int hh = c >> 6, q = c & 63; return OFF_A + t * 256 + hh * 64 + (q >> 1) + 32 * (q & 1); }
        case 2: return OFF_A + 512 + c;
        case 3: case 4: { const int sub = c >> 5, q = c & 31; return OFF_C + (t - 3) * 256 + sub * 32 + (q >> 1) + 16 * (q & 1); }
        case 5: return OFF_C + 512 + c;
        case 6: case 7: case 8: return OFF_D + (t - 6) * 256 + c;
        case 9: return OFF_B + c;
        case 10: { if (c < 128) return OFF_B + 256 + c; if (c < 160) { const int q = c - 128; return OFF_B + 640 + (q >> 1) + 16 * (q & 1); } return -1; }
        default: return OFF_B + 384 + c;
    }
}

template <bool THROUGH>
__device__ __forceinline__ void transpose_item(const float* W, int K, int N, const float* gain, bf16* WT, int mt, int nblk, LAS float* scr, int item, int lane) {
    const int kb = item / nblk, nb = item % nblk, k0 = 64 * kb, n0 = 32 * nb;
    const int src = map_col(mt, n0 + (lane & 31));
    float v[32];
#pragma unroll
    for (int i = 0; i < 32; ++i) { const int kk = 2 * i + (lane >> 5); v[i] = (src >= 0) ? W[(size_t)(k0 + kk) * N + src] : 0.f; }
#pragma unroll
    for (int i = 0; i < 32; ++i) { const int kk = 2 * i + (lane >> 5); float x = v[i]; if (gain && src >= 0) x *= gain[k0 + kk]; scr[kk * 33 + (lane & 31)] = x; }
    LDS_WAIT(); asm volatile("" ::: "memory");
    const int c = lane & 7;
#pragma unroll
    for (int j = 0; j < 4; ++j) { const int n = (lane >> 3) + 8 * j; const LAS float* s = scr + (8 * c) * 33 + n;
        v4u o; o.x = pk2(s[0 * 33], s[1 * 33]); o.y = pk2(s[2 * 33], s[3 * 33]); o.z = pk2(s[4 * 33], s[5 * 33]); o.w = pk2(s[6 * 33], s[7 * 33]);
        if (THROUGH) asm volatile("global_store_dwordx4 %0, %1, off sc1" :: "v"(WT + (size_t)(n0 + n) * K + k0 + 8 * c), "v"(o) : "memory"); else *(GAS v4u*)(WT + (size_t)(n0 + n) * K + k0 + 8 * c) = o; }
    LDS_WAIT(); asm volatile("" ::: "memory");
}

namespace epi {
using pg8::f32x4; using pg8::u32x4; using pg8::Unit; using pg8::bf16_t;
constexpr int BM = 256, HALF = 128;

__device__ __forceinline__ u32x4 pack8(const f32x4& a, const f32x4& b) {
    u32x4 w; w.x = cvt_pk_bf16(a[0], a[1]); w.y = cvt_pk_bf16(a[2], a[3]); w.z = cvt_pk_bf16(b[0], b[1]); w.w = cvt_pk_bf16(b[2], b[3]); return w;
}
__device__ __forceinline__ void rope8(f32x4& a, f32x4& b, const f32x4& cs01, const f32x4& cs23) {
    const float a0 = a[0] * cs01[0] - a[1] * cs01[1], a1 = a[0] * cs01[1] + a[1] * cs01[0];
    const float a2 = a[2] * cs01[2] - a[3] * cs01[3], a3 = a[2] * cs01[3] + a[3] * cs01[2];
    const float b0 = b[0] * cs23[0] - b[1] * cs23[1], b1 = b[0] * cs23[1] + b[1] * cs23[0];
    const float b2 = b[2] * cs23[2] - b[3] * cs23[3], b3 = b[2] * cs23[3] + b[3] * cs23[2];
    a = (f32x4){a0, a1, a2, a3}; b = (f32x4){b0, b1, b2, b3};
}
__device__ __forceinline__ void rot_step(f32x4& t, const f32x4& d) {
    const float c0 = t[0] * d[0] - t[1] * d[1], s0 = t[1] * d[0] + t[0] * d[1], c1 = t[2] * d[2] - t[3] * d[3], s1 = t[3] * d[2] + t[2] * d[3];
    t = (f32x4){c0, s0, c1, s1};
}
__device__ __forceinline__ float sumsq8(const f32x4& a, const f32x4& b) { return (a[0] * a[0] + a[1] * a[1]) + (a[2] * a[2] + a[3] * a[3]) + (b[0] * b[0] + b[1] * b[1]) + (b[2] * b[2] + b[3] * b[3]); }
__device__ __forceinline__ float red_fq(float s) {
    auto a = __builtin_amdgcn_permlane16_swap(__float_as_uint(s), __float_as_uint(s), false, false); s = __uint_as_float(a[0]) + __uint_as_float(a[1]);
    auto b = __builtin_amdgcn_permlane32_swap(__float_as_uint(s), __float_as_uint(s), false, false); return __uint_as_float(b[0]) + __uint_as_float(b[1]);
}
__device__ __forceinline__ float sum16(const float* p) { const f32x4 a = *(const f32x4*)p, b = *(const f32x4*)(p + 4), c = *(const f32x4*)(p + 8), d = *(const f32x4*)(p + 12);
    return ((a[0] + a[1]) + (a[2] + a[3])) + ((b[0] + b[1]) + (b[2] + b[3])) + ((c[0] + c[1]) + (c[2] + c[3])) + ((d[0] + d[1]) + (d[2] + d[3])); }

__device__ __forceinline__ float row_ssq(const float* ssq, int row, int fq) { const f32x4 a = *(const f32x4*)(ssq + (size_t)row * 16 + 4 * fq); return red_fq((a[0] + a[1]) + (a[2] + a[3])); }

template <int MSTEP = 16>
__device__ __forceinline__ void batch_rs(float (&rs)[8], const float* ssq, int stride, int nq, int row0, int fq, float num, float inv_dim) {
    f32x4 v[8];
#pragma unroll
    for (int i = 0; i < 8; ++i) v[i] = (fq < nq) ? *(const f32x4*)(ssq + (size_t)(row0 + (i >> 2) * HALF + (i & 3) * MSTEP) * stride + 4 * fq) : (f32x4){0.f, 0.f, 0.f, 0.f};
#pragma unroll
    for (int i = 0; i < 8; ++i) rs[i] = num / sqrtf(red_fq((v[i][0] + v[i][1]) + (v[i][2] + v[i][3])) * inv_dim + NORM_EPS);
}

struct EpiIn {
    static constexpr bool PERM = true, AFTER_DRAIN = false, STAGED = true, AROWPERM = false;
    unsigned char* ws; PG8_LAS float* rsl;
    struct Carry { int pm; };
    __device__ __forceinline__ void stage(const Unit&, int, int, int) const {}
    template <int MODE>
    __device__ __forceinline__ void body(const f32x4 (&acc)[2][2][4][2], const Unit& u, int wr, int wc, size_t doff, int ld, int coff, float sc, Carry& cy) const {
        const float* cs64 = (const float*)(ws + WS_TAB64); const float* cs32 = (const float*)(ws + WS_TAB32);
        float* ssq_cq = (float*)(ws + WS_SSQCQ); float* ssq_ckv = (float*)(ws + WS_SSQCKV); bf16_t* KB = (bf16_t*)(ws + X_KB);
        bf16_t* dst = (bf16_t*)(ws + doff);
        const int lane_ = pg8::lane_now(), fr_ = lane_ & 15, fq = lane_ >> 4; const int row0 = u.pm * BM + wr * 64 + fr_;
        float rs[8]; { PG8_LAS float* rsw = rsl + ((wr * 4 + wc) * 128 + fr_);
          if (cy.pm != u.pm) { batch_rs(rs, (const float*)(ws + WS_SSQA), 16, 4, row0, fq, 1.0f, 1.0f / DMODEL); cy.pm = u.pm;
              if (fq == 0) {
#pragma unroll
                  for (int it = 0; it < 8; ++it) rsw[it * 16] = rs[it]; } }
          else {
#pragma unroll
              for (int it = 0; it < 8; ++it) rs[it] = rsw[it * 16]; }
#pragma unroll
          for (int it = 0; it < 8; ++it) rs[it] *= sc; }
        constexpr bool rope = (MODE == 1 || MODE == 2 || MODE == 4);
        const float* tab = (MODE == 1) ? cs64 : cs32; constexpr int tw = (MODE == 1) ? 32 : 16;
        int j0[2];
#pragma unroll
        for (int bj = 0; bj < 2; ++bj) { const int ct = bj * HALF + wc * 32 + 8 * fq; j0[bj] = (MODE == 1) ? ((ct & 63) >> 1) : (MODE == 2) ? ((ct & 31) >> 1) : 4 * fq; }
        f32x4 T[2][4], D[4];
        if constexpr (rope) {
#pragma unroll
            for (int bj = 0; bj < 2; ++bj) {
                if (MODE == 4 && bj == 0) continue;
#pragma unroll
                for (int ai = 0; ai < 2; ++ai) { const float* tp = tab + ((size_t)((row0 + ai * HALF) & (SEQ - 1)) * tw + j0[bj]) * 2; T[ai][2 * bj] = *(const f32x4*)tp; T[ai][2 * bj + 1] = *(const f32x4*)(tp + 4); }
                const float* dp = tab + ((size_t)16 * tw + j0[bj]) * 2; D[2 * bj] = *(const f32x4*)dp; D[2 * bj + 1] = *(const f32x4*)(dp + 4);
            }
        }
#pragma unroll
        for (int it = 0; it < 8; ++it) {
            const int ai = it >> 2, m = it & 3;
            const int row = row0 + ai * HALF + m * 16;
            float ss = 0.f;
#pragma unroll
            for (int bj = 0; bj < 2; ++bj) {
                const int ct = bj * HALF + wc * 32 + 8 * fq;
                f32x4 a = acc[ai][bj][m][0] * rs[it], b = acc[ai][bj][m][1] * rs[it];
                if constexpr (MODE == 1 || MODE == 2) rope8(a, b, T[ai][2 * bj], T[ai][2 * bj + 1]);
                if (MODE == 4 && bj == 1) {
                    if (wc == 0) {
                        rope8(a, b, T[ai][2], T[ai][3]);
                        const u32x4 w = pack8(a, b);
#pragma unroll
                        for (int hh = 0; hh < 4; ++hh) *(u32x4*)(KB + (size_t)row * 384 + hh * 96 + 64 + 8 * fq) = w;
                    }
                } else {
                    if constexpr (MODE >= 3) ss += sumsq8(a, b);
                    const int cc = (MODE == 4) ? (wc * 32 + 8 * fq) : ct;
                    *(u32x4*)(dst + (size_t)row * ld + coff + cc) = pack8(a, b);
                }
            }
            if constexpr (MODE >= 3) { ss = red_fq(ss);
                if (fq == 0) { if (MODE == 3) ssq_cq[(size_t)row * 8 + wc] = ss; else if (MODE == 4) ssq_cq[(size_t)row * 8 + 4 + wc] = ss; else ssq_ckv[(size_t)row * 4 + wc] = ss; } }
            if constexpr (rope) { if (m < 3) {
#pragma unroll
                for (int k = (MODE == 4 ? 2 : 0); k < 4; ++k) rot_step(T[ai][k], D[k]); } }
            asm volatile("" ::: "memory");
        }
    }
    __device__ __forceinline__ void operator()(const f32x4 (&acc)[2][2][4][2], const Unit& u, int wr, int wc, int fr, int fq, Carry& cy, int) const {
        switch (u.pn) {
            case 0: body<1>(acc, u, wr, wc, X_QO, 1024, 0, SC_A, cy); break;
            case 1: body<1>(acc, u, wr, wc, X_KA, 256, 0, 1.f, cy); break;
            case 2: body<0>(acc, u, wr, wc, X_VA, 256, 0, 1.f, cy); break;
            case 3: body<2>(acc, u, wr, wc, X_QO, 1024, 512, SC_C, cy); break;
            case 4: body<2>(acc, u, wr, wc, X_KC, 256, 0, 1.f, cy); break;
            case 5: body<0>(acc, u, wr, wc, X_VC, 256, 0, 1.f, cy); break;
            case 6: body<0>(acc, u, wr, wc, X_QO, 1024, 768, SC_D, cy); break;
            case 7: body<0>(acc, u, wr, wc, X_KD, 256, 0, 1.f, cy); break;
            case 8: body<0>(acc, u, wr, wc, X_VD, 256, 0, 1.f, cy); break;
            case 9: body<3>(acc, u, wr, wc, X_CQ, 384, 0, 1.f, cy); break;
            case 10: body<4>(acc, u, wr, wc, X_CQ, 384, 256, 1.f, cy); break;
            default: body<5>(acc, u, wr, wc, X_CKV, 256, 0, 1.f, cy); break;
        }
    }
};

struct EpiMla {
    static constexpr bool PERM = true, AFTER_DRAIN = false, STAGED = false, AROWPERM = false; struct Carry {};
    int mode; unsigned char* ws;
    __device__ __forceinline__ void operator()(const f32x4 (&acc)[2][2][4][2], const Unit& u, int wr, int wc, int fr, int fq) const {
        const float* cs32 = (const float*)(ws + WS_TAB32);
        bf16_t* QB = (bf16_t*)(ws + X_QB); bf16_t* KB = (bf16_t*)(ws + X_KB); bf16_t* VB = (bf16_t*)(ws + X_VB);
        const int lane_ = pg8::lane_now(), fr_ = lane_ & 15; fq = lane_ >> 4; const int row0 = u.pm * BM + wr * 64 + fr_;
        float rs[8];
        if (mode == 0) batch_rs(rs, (const float*)(ws + WS_SSQCQ), 8, 2, row0, fq, SC_B, 1.0f / 384.0f); else batch_rs(rs, (const float*)(ws + WS_SSQCKV), 4, 1, row0, fq, 1.0f, 1.0f / 256.0f);
        f32x4 T[2][4], D[4]; bool rot[2];
#pragma unroll
        for (int bj = 0; bj < 2; ++bj) { const int c8 = u.pn * BM + bj * HALF + wc * 32 + 8 * fq, w = c8 % 96; rot[bj] = (mode == 0) && c8 < 384 && w >= 64; const int j0 = rot[bj] ? ((w - 64) >> 1) : 0;
#pragma unroll
            for (int ai = 0; ai < 2; ++ai) { const float* tp = cs32 + ((size_t)((row0 + ai * HALF) & (SEQ - 1)) * 16 + j0) * 2;
                if (mode == 0) { T[ai][2 * bj] = *(const f32x4*)tp; T[ai][2 * bj + 1] = *(const f32x4*)(tp + 4); } else { T[ai][2 * bj] = (f32x4){1.f, 0.f, 1.f, 0.f}; T[ai][2 * bj + 1] = (f32x4){1.f, 0.f, 1.f, 0.f}; } }
            const float* dp = cs32 + ((size_t)16 * 16 + j0) * 2;
            if (mode == 0) { D[2 * bj] = *(const f32x4*)dp; D[2 * bj + 1] = *(const f32x4*)(dp + 4); } else { D[2 * bj] = (f32x4){1.f, 0.f, 1.f, 0.f}; D[2 * bj + 1] = (f32x4){1.f, 0.f, 1.f, 0.f}; } }
#pragma unroll
        for (int it = 0; it < 8; ++it) {
            const int ai = it >> 2, m = it & 3;
            const int row = row0 + ai * HALF + m * 16;
#pragma unroll
            for (int bj = 0; bj < 2; ++bj) {
                const int c8 = u.pn * BM + bj * HALF + wc * 32 + 8 * fq;
                f32x4 a = acc[ai][bj][m][0] * rs[it], b = acc[ai][bj][m][1] * rs[it];
                if (mode == 0) {
                    if (c8 < 384) {
                        f32x4 ra = a, rb = b; rope8(ra, rb, T[ai][2 * bj], T[ai][2 * bj + 1]);
                        if (rot[bj]) { a = ra; b = rb; }
                        *(u32x4*)(QB + (size_t)row * 384 + c8) = pack8(a, b);
                    }
                } else if (u.pn == 0) { const int hh = c8 >> 6, d = c8 & 63; *(u32x4*)(KB + (size_t)row * 384 + hh * 96 + d) = pack8(a, b); }
                else *(u32x4*)(VB + (size_t)row * 256 + (c8 - 256)) = pack8(a, b);
            }
            if (mode == 0 && m < 3) {
#pragma unroll
                for (int k = 0; k < 4; ++k) rot_step(T[ai][k], D[k]); }
            if (it & 1) asm volatile("" ::: "memory");
        }
    }
};

__device__ __forceinline__ void unpack8(const u32x4& w, f32x4& a, f32x4& b) { a = (f32x4){bflo(w.x), bfhi(w.x), bflo(w.y), bfhi(w.y)}; b = (f32x4){bflo(w.z), bfhi(w.z), bflo(w.w), bfhi(w.w)}; }
struct EpiRes {
    static constexpr bool PERM = true, AFTER_DRAIN = false, STAGED = false, AROWPERM = false; struct Carry {};
    const bf16_t* hin; bf16_t* hout; float* ssq; bool dry;
    __device__ __forceinline__ void operator()(const f32x4 (&acc)[2][2][4][2], const Unit& u, int wr, int wc, int fr, int fq) const {
        const int lane_ = pg8::lane_now(), fr_ = lane_ & 15; fq = lane_ >> 4; const int row0 = u.pm * BM + wr * 64 + fr_;
        const int c0 = u.pn * BM + wc * 32 + 8 * fq;
        u32x4 H[8][2];
#pragma unroll
        for (int it = 0; it < 8; ++it)
#pragma unroll
            for (int bj = 0; bj < 2; ++bj) H[it][bj] = *(const u32x4*)(hin + (size_t)(row0 + (it >> 2) * HALF + (it & 3) * 16) * DMODEL + c0 + bj * HALF);
#pragma unroll
        for (int it = 0; it < 8; ++it) {
            const int ai = it >> 2, m = it & 3;
            const int row = row0 + ai * HALF + m * 16;
            float ss = 0.f;
#pragma unroll
            for (int bj = 0; bj < 2; ++bj) {
                f32x4 a, b; unpack8(H[it][bj], a, b);
                a = a + acc[ai][bj][m][0]; b = b + acc[ai][bj][m][1];
                if (!dry) *(u32x4*)(hout + (size_t)row * DMODEL + c0 + bj * HALF) = pack8(a, b);
                ss += sumsq8(a, b);
            }
            ss = red_fq(ss);
            if (dry) asm volatile("" :: "v"(ss)); else if (fq == 0) ssq[(size_t)row * 16 + u.pn * 4 + wc] = ss;
            asm volatile("" ::: "memory");
        }
    }
};

struct EpiSpill {
    static constexpr bool PERM = true, AFTER_DRAIN = false, STAGED = false, AROWPERM = false; struct Carry {};
    bf16_t* esc_base;
    __device__ __forceinline__ void operator()(const f32x4 (&acc)[2][2][4][2], const Unit& u, int wr, int wc, int fr, int fq) const {
        const int tid = ((wr * 4 + wc) << 6) | pg8::lane_now();
        bf16_t* esc = esc_base + (size_t)((u.pm >> 3) * 32 + u.pn * 8 + (u.pm & 7)) * 65536;
#pragma unroll
        for (int ai = 0; ai < 2; ++ai)
#pragma unroll
            for (int m = 0; m < 4; ++m)
#pragma unroll
                for (int bj = 0; bj < 2; ++bj)
                    *(u32x4*)(esc + ((size_t)(((ai * 2 + bj) * 4 + m) * NTHREADS + tid)) * 8) = pack8(acc[ai][bj][m][0], acc[ai][bj][m][1]);
    }
};
struct EpiPle {
    static constexpr bool PERM = true, AFTER_DRAIN = false, STAGED = false, AROWPERM = false; struct Carry {};
    const float* ssq; const bf16_t* esc; const bf16_t* hin; bf16_t* hout; float* ssq_out; bool dry;
    __device__ __forceinline__ void operator()(const f32x4 (&acc)[2][2][4][2], const Unit& u, int wr, int wc, int fr, int fq) const {
        const int lane_ = pg8::lane_now(), fr_ = lane_ & 15; const int tid = ((wr * 4 + wc) << 6) | lane_; fq = lane_ >> 4; const int row0 = u.pm * BM + wr * 64 + fr_;
        const int c0 = u.pn * BM + wc * 32 + 8 * fq;
        float rs[8]; batch_rs(rs, ssq, 16, 4, row0, fq, -LOG2E, 1.0f / DMODEL);
#pragma unroll
        for (int ai = 0; ai < 2; ++ai) {
            u32x4 H[4][2], E[4][2];
#pragma unroll
            for (int m = 0; m < 4; ++m)
#pragma unroll
                for (int bj = 0; bj < 2; ++bj) { H[m][bj] = *(const u32x4*)(hin + (size_t)(row0 + ai * HALF + m * 16) * DMODEL + c0 + bj * HALF);
                    E[m][bj] = *(const u32x4*)(esc + ((size_t)(((ai * 2 + bj) * 4 + m) * NTHREADS + tid)) * 8); }
#pragma unroll
            for (int m = 0; m < 4; ++m) {
                const int it = ai * 4 + m, row = row0 + ai * HALF + m * 16;
                float ss = 0.f;
#pragma unroll
                for (int bj = 0; bj < 2; ++bj) {
                    f32x4 a, b, ea, eb; unpack8(H[m][bj], a, b); unpack8(E[m][bj], ea, eb);
                    const f32x4 ga = acc[ai][bj][m][0] * rs[it], gb = acc[ai][bj][m][1] * rs[it];
#pragma unroll
                    for (int e = 0; e < 4; ++e) { a[e] += ea[e] * fast_rcp(1.0f + fast_exp2(ga[e])); b[e] += eb[e] * fast_rcp(1.0f + fast_exp2(gb[e])); }
                    if (!dry) *(u32x4*)(hout + (size_t)row * DMODEL + c0 + bj * HALF) = pack8(a, b);
                    ss += sumsq8(a, b);
                }
                ss = red_fq(ss);
                if (dry) asm volatile("" :: "v"(ss)); else if (fq == 0) ssq_out[(size_t)row * 16 + u.pn * 4 + wc] = ss;
                asm volatile("" ::: "memory");
            }
        }
    }
};

template <int CTRL> __device__ __forceinline__ float dpp(float old, float src) {
    return __int_as_float(__builtin_amdgcn_update_dpp(__float_as_int(old), __float_as_int(src), CTRL, 0xf, 0xf, false));
}
template <int NEXT> __device__ __forceinline__ float dpp_rot(float src) { float d;
    if (NEXT) asm("v_mov_b32_dpp %0, %1 row_ror:15 row_mask:0xf bank_mask:0xf" : "=v"(d) : "v"(src)); else asm("v_mov_b32_dpp %0, %1 row_ror:1 row_mask:0xf bank_mask:0xf" : "=v"(d) : "v"(src));
    return d; }
template <int NEXT> __device__ __forceinline__ float dpp_into(float old, float src) { float d;
    if (NEXT) asm("v_mov_b32_dpp %0, %2 row_shl:1 row_mask:0xf bank_mask:0xf" : "=v"(d) : "0"(old), "v"(src)); else asm("v_mov_b32_dpp %0, %2 row_shr:1 row_mask:0xf bank_mask:0xf" : "=v"(d) : "0"(old), "v"(src));
    return d; }
struct EpiUpConv {
    static constexpr bool PERM = true, AFTER_DRAIN = false, STAGED = true, AROWPERM = true;
    const float* ssq; bf16_t* act; float* halo; const float* cw; const float* cb; PG8_LAS float* xl; PG8_LAS float* cwl; PG8_LAS float* rsl;
    struct Carry { int pm; };
    __device__ __forceinline__ void stage(const Unit& u, int buf, int wid, int lane) const {
        if (wid < 4) {
            const int kind = 2 * wid + (lane >> 5), k3 = kind & 3, col = (kind >= 4 ? DFF : 0) + u.pn * HALF + (lane & 31) * 4;
            const float* src = (k3 == 3) ? cb + col : cw + (size_t)k3 * NUP + col;
            __builtin_amdgcn_global_load_lds((const unsigned*)src, (PG8_LAS unsigned*)(cwl + buf * 1024 + wid * 256), 16, 0, 0);
        }
    }
    __device__ __forceinline__ void operator()(f32x4 (&acc)[2][2][4][2], const Unit& u, int wr, int wc, int fr, int fq, Carry& cy, int buf) const {
        const int lane_ = pg8::lane_now(), fr_ = lane_ & 15; fq = lane_ >> 4; const int row0 = u.pm * BM + wr * 64 + 4 * fr_;
        const int ct = wc * 32 + 8 * fq;
        { float rs[8]; PG8_LAS float* rsw = rsl + ((wr * 4 + wc) * 128 + fr_);
          if (cy.pm != u.pm) { batch_rs<1>(rs, ssq, 16, 4, row0, fq, 1.0f, 1.0f / DMODEL); cy.pm = u.pm;
              if (fq == 0) {
#pragma unroll
                  for (int it = 0; it < 8; ++it) rsw[it * 16] = rs[it]; } }
          else {
#pragma unroll
              for (int it = 0; it < 8; ++it) rs[it] = rsw[it * 16]; }
#pragma unroll
          for (int it = 0; it < 8; ++it)
#pragma unroll
              for (int bj = 0; bj < 2; ++bj) { acc[it >> 2][bj][it & 3][0] *= rs[it]; acc[it >> 2][bj][it & 3][1] *= rs[it]; } }
#pragma unroll
        for (int ai = 0; ai < 2; ++ai)
#pragma unroll
            for (int bj = 0; bj < 2; ++bj)
                asm volatile("" : "+v"(acc[ai][bj][0][0]), "+v"(acc[ai][bj][0][1]), "+v"(acc[ai][bj][1][0]), "+v"(acc[ai][bj][1][1]), "+v"(acc[ai][bj][2][0]), "+v"(acc[ai][bj][2][1]), "+v"(acc[ai][bj][3][0]), "+v"(acc[ai][bj][3][1]));
        f32x4 CW[2][8];
#pragma unroll
        for (int n = 0; n < 2; ++n)
#pragma unroll
            for (int k = 0; k < 8; ++k) CW[n][k] = *(const PG8_LAS f32x4*)(cwl + buf * 1024 + k * 128 + ct + 4 * n);
#pragma unroll
        for (int ai = 0; ai < 2; ++ai) {
            const int q = 2 * ai + wr;
#pragma unroll
            for (int bj = 0; bj < 2; ++bj)
#pragma unroll
                for (int n = 0; n < 2; ++n) {
                    if (fr_ == 0) *(PG8_LAS f32x4*)(xl + (q * 2 + 0) * 256 + bj * HALF + ct + 4 * n) = acc[ai][bj][0][n];
                    if (fr_ == 15) *(PG8_LAS f32x4*)(xl + (q * 2 + 1) * 256 + bj * HALF + ct + 4 * n) = acc[ai][bj][3][n];
                    if (q == 0 && fr_ == 0) { *(f32x4*)(halo + ((size_t)u.pm * 4 + 0) * NUP + u.pn * BM + bj * HALF + ct + 4 * n) = acc[ai][bj][0][n];
                                              *(f32x4*)(halo + ((size_t)u.pm * 4 + 1) * NUP + u.pn * BM + bj * HALF + ct + 4 * n) = acc[ai][bj][1][n]; }
                    if (q == 3 && fr_ == 15) { *(f32x4*)(halo + ((size_t)u.pm * 4 + 2) * NUP + u.pn * BM + bj * HALF + ct + 4 * n) = acc[ai][bj][2][n];
                                               *(f32x4*)(halo + ((size_t)u.pm * 4 + 3) * NUP + u.pn * BM + bj * HALF + ct + 4 * n) = acc[ai][bj][3][n]; }
                }
        }
        asm volatile("s_waitcnt lgkmcnt(0)" ::: "memory"); __builtin_amdgcn_s_barrier(); asm volatile("" ::: "memory");
#pragma unroll
        for (int ai = 0; ai < 2; ++ai) {
            const int q = 2 * ai + wr;
            const f32x4 zero = (f32x4){0.f, 0.f, 0.f, 0.f};
            f32x4 hpg[2], hpv[2], hng[2], hnv[2];
#pragma unroll
            for (int n = 0; n < 2; ++n) { hpg[n] = (q > 0) ? *(const PG8_LAS f32x4*)(xl + ((q - 1) * 2 + 1) * 256 + ct + 4 * n) : zero; hpv[n] = (q > 0) ? *(const PG8_LAS f32x4*)(xl + ((q - 1) * 2 + 1) * 256 + HALF + ct + 4 * n) : zero; }
#pragma unroll
            for (int m = 0; m < 4; ++m) {
                if (m == 2) {
#pragma unroll
                    for (int n = 0; n < 2; ++n) { hng[n] = (q < 3) ? *(const PG8_LAS f32x4*)(xl + ((q + 1) * 2 + 0) * 256 + ct + 4 * n) : zero; hnv[n] = (q < 3) ? *(const PG8_LAS f32x4*)(xl + ((q + 1) * 2 + 0) * 256 + HALF + ct + 4 * n) : zero; }
                }
                u32x4 w;
#pragma unroll
                for (int n = 0; n < 2; ++n) {
                    const f32x4 g0 = CW[n][0], g1 = CW[n][1], g2 = CW[n][2], gb = CW[n][3], v0 = CW[n][4], v1 = CW[n][5], v2 = CW[n][6], vb = CW[n][7];
#pragma unroll
                    for (int ep = 0; ep < 2; ++ep) {
                        const int e0 = 2 * ep, e1 = e0 + 1;
                        const pg8::f32x2 cg2 = {acc[ai][0][m][n][e0], acc[ai][0][m][n][e1]}, cv2 = {acc[ai][1][m][n][e0], acc[ai][1][m][n][e1]};
                        pg8::f32x2 pg2, pv2, ng2, nv2;
                        if (m == 0) { pg2.x = dpp_into<0>(hpg[n][e0], acc[ai][0][3][n][e0]); pg2.y = dpp_into<0>(hpg[n][e1], acc[ai][0][3][n][e1]); pv2.x = dpp_into<0>(hpv[n][e0], acc[ai][1][3][n][e0]); pv2.y = dpp_into<0>(hpv[n][e1], acc[ai][1][3][n][e1]); }
                        else { pg2 = (pg8::f32x2){acc[ai][0][m > 0 ? m - 1 : 0][n][e0], acc[ai][0][m > 0 ? m - 1 : 0][n][e1]}; pv2 = (pg8::f32x2){acc[ai][1][m > 0 ? m - 1 : 0][n][e0], acc[ai][1][m > 0 ? m - 1 : 0][n][e1]}; }
                        if (m == 3) { ng2.x = dpp_into<1>(hng[n][e0], acc[ai][0][0][n][e0]); ng2.y = dpp_into<1>(hng[n][e1], acc[ai][0][0][n][e1]); nv2.x = dpp_into<1>(hnv[n][e0], acc[ai][1][0][n][e0]); nv2.y = dpp_into<1>(hnv[n][e1], acc[ai][1][0][n][e1]); }
                        else { ng2 = (pg8::f32x2){acc[ai][0][m < 3 ? m + 1 : 3][n][e0], acc[ai][0][m < 3 ? m + 1 : 3][n][e1]}; nv2 = (pg8::f32x2){acc[ai][1][m < 3 ? m + 1 : 3][n][e0], acc[ai][1][m < 3 ? m + 1 : 3][n][e1]}; }
                        const pg8::f32x2 x2 = (pg8::f32x2){gb[e0], gb[e1]} + (pg8::f32x2){g0[e0], g0[e1]} * pg2 + (pg8::f32x2){g1[e0], g1[e1]} * cg2 + (pg8::f32x2){g2[e0], g2[e1]} * ng2;
                        const pg8::f32x2 y2 = (pg8::f32x2){vb[e0], vb[e1]} + (pg8::f32x2){v0[e0], v0[e1]} * pv2 + (pg8::f32x2){v1[e0], v1[e1]} * cv2 + (pg8::f32x2){v2[e0], v2[e1]} * nv2;
                        constexpr float KG = -2.0f * LOG2E * 0.7978845608028654f;
                        const pg8::f32x2 a2 = x2 * ((x2 * x2) * (pg8::f32x2){KG * 0.044715f, KG * 0.044715f} + (pg8::f32x2){KG, KG});
                        const pg8::f32x2 d2 = (pg8::f32x2){fast_exp2(a2.x), fast_exp2(a2.y)} + (pg8::f32x2){1.0f, 1.0f};
                        const pg8::f32x2 o2 = (x2 * (pg8::f32x2){fast_rcp(d2.x), fast_rcp(d2.y)}) * y2;
                        const unsigned pk = cvt_pk_bf16(o2.x, o2.y);
                        if (n == 0) { if (ep == 0) w.x = pk; else w.y = pk; } else { if (ep == 0) w.z = pk; else w.w = pk; }
                    }
                }
                *(u32x4*)(act + (size_t)(row0 + ai * HALF + m) * DFF + u.pn * HALF + ct) = w;
            }
            asm volatile("" ::: "memory");
        }
    }
};
}

struct Frame {
    LAS unsigned char* lds;
    int tid, lane, wave, vcu, G;
    unsigned char* ws;
};
#define FRAME_TID(F_) Frame F = F_; { const int l_ = pg8::lane_now(); F.lane = l_; F.tid = (F.wave << 6) | l_; }
#define WSP(T, off) ((T*)(F.ws + (off)))

template <bool THROUGH>
__device__ __forceinline__ void convert_layer_weights(const Frame& F, const ArgView& A, int l, int gw, int NGW) {
    LAS float* scr = (LAS float*)(F.lds + F.wave * 16384);
    constexpr int I_1 = (1024 / 64) * (N1 / 32), I_UP = (1024 / 64) * (NUP / 32), I_DN = (DFF / 64) * (1024 / 32), I_O = 16 * 32, I_G = 16 * 32, I_PP = 4 * 32, I_UQ = 6 * 16, I_UKV = 4 * 16;
    constexpr int NIT = I_1 + I_UP + I_DN + I_O + I_G + I_PP + I_UQ + I_UKV;
    unsigned char* wl = F.ws + WS_W + (size_t)l * W_STRIDE;
    for (int it = gw; it < NIT; it += NGW) {
        int r = it;
        if (r < I_1) { transpose_item<THROUGH>(A.in(I_W_IN) + (size_t)l * 1024 * IN_COLS, 1024, IN_COLS, A.in(I_ATTN_NORM) + l * 1024, (bf16*)(wl + W_1T), MAP_IN, N1 / 32, scr, r, F.lane); continue; } r -= I_1;
        if (r < I_UP) { transpose_item<THROUGH>(A.in(I_W_UP) + (size_t)l * 1024 * NUP, 1024, NUP, A.in(I_FFN_NORM) + l * 1024, (bf16*)(wl + W_UPT), MAP_UP, NUP / 32, scr, r, F.lane); continue; } r -= I_UP;
        if (r < I_DN) { transpose_item<THROUGH>(A.in(I_W_DOWN) + (size_t)l * DFF * 1024, DFF, 1024, nullptr, (bf16*)(wl + W_DNT), MAP_ID, 32, scr, r, F.lane); continue; } r -= I_DN;
        if (r < I_O) { transpose_item<THROUGH>(A.in(I_W_O) + (size_t)l * 1024 * 1024, 1024, 1024, nullptr, (bf16*)(wl + W_OT), MAP_ID, 32, scr, r, F.lane); continue; } r -= I_O;
        if (r < I_G) { transpose_item<THROUGH>(A.in(I_W_G) + (size_t)l * 1024 * 1024, 1024, 1024, A.in(I_PLE_NORM) + l * 1024, (bf16*)(wl + W_GT), MAP_ID, 32, scr, r, F.lane); continue; } r -= I_G;
        if (r < I_PP) { transpose_item<THROUGH>(A.in(I_W_PP) + (size_t)l * 256 * 1024, 256, 1024, nullptr, (bf16*)(wl + W_PPT), MAP_ID, 32, scr, r, F.lane); continue; } r -= I_PP;
        if (r < I_UQ) { transpose_item<THROUGH>(A.in(I_W_UQ) + (size_t)l * 384 * 384, 384, 384, A.in(I_QNORM) + l * 384, (bf16*)(wl + W_UQT), MAP_UQ, 16, scr, r, F.lane); continue; } r -= I_UQ;
        transpose_item<THROUGH>(A.in(I_W_UKV) + (size_t)l * 256 * 512, 256, 512, A.in(I_KVNORM) + l * 256, (bf16*)(wl + W_UKVT), MAP_UKV, 16, scr, r, F.lane);
    }
}
__device__ __forceinline__ void convert_next_layer(const Frame& F0, const ArgView& A, int lnext, int idx, int n) {
    FRAME_TID(F0);
    convert_layer_weights<true>(F, A, lnext, idx * NWAVES + F.wave, n * NWAVES);
    asm volatile("s_waitcnt vmcnt(0) lgkmcnt(0)" ::: "memory");
    __syncthreads();
}
template <int N> struct IntC { static constexpr int value = N; };
__device__ __forceinline__ void prologue_phase(const Frame& F0, const ArgView& A) {
    FRAME_TID(F0);
    const int gw = F.vcu * NWAVES + F.wave, NGW = F.G * NWAVES;
    convert_layer_weights<false>(F, A, 0, gw, NGW);
    {
        const float* src = A.in(I_X); bf16* hb = WSP(bf16, WS_HBA); float* ssq = WSP(float, WS_SSQA);
        auto rows = [&](auto UC, int m0) { constexpr int U = decltype(UC)::value;
            f32x4 v[U][4];
#pragma unroll
            for (int u = 0; u < U; ++u) { const GAS f32x4* xr = (const GAS f32x4*)(src + (size_t)(m0 + u * NGW) * DMODEL) + F.lane;
#pragma unroll
                for (int j = 0; j < 4; ++j) v[u][j] = xr[64 * j]; }
#pragma unroll
            for (int u = 0; u < U; ++u) { const int m = m0 + u * NGW; float s = 0.f;
#pragma unroll
                for (int j = 0; j < 4; ++j) s += (v[u][j].x * v[u][j].x + v[u][j].y * v[u][j].y) + (v[u][j].z * v[u][j].z + v[u][j].w * v[u][j].w);
                s = wave_sum(s);
                GAS unsigned long long* o8 = (GAS unsigned long long*)(hb + (size_t)m * DMODEL) + F.lane;
#pragma unroll
                for (int j = 0; j < 4; ++j) o8[64 * j] = (unsigned long long)pk2(v[u][j].x, v[u][j].y) | ((unsigned long long)pk2(v[u][j].z, v[u][j].w) << 32);
                if (F.lane < 16) ssq[(size_t)m * 16 + F.lane] = (F.lane == 0) ? s : 0.f; } };
        int m = gw;
        for (; m + 3 * NGW < M; m += 4 * NGW) rows(IntC<4>{}, m);
        for (; m < M; m += NGW) rows(IntC<1>{}, m);
    }
    {
        const int gt = F.vcu * NTHREADS + F.tid, NT = F.G * NTHREADS;
        float* t64 = WSP(float, WS_TAB64); float* t32 = WSP(float, WS_TAB32);
        for (int i = gt; i < SEQ * 48; i += NT) {
            const int pos = i / 48, j = i % 48;
            float* dst;
            if (j < 32) dst = t64 + ((size_t)pos * 32 + j) * 2; else dst = t32 + ((size_t)pos * 16 + (j - 32)) * 2;
            const float inv = ROPE_INV[j];
            float s, c; sincos_acc((float)pos * inv, s, c);
            dst[0] = c; dst[1] = s;
        }
    }
}

__device__ __forceinline__ void final_phase(const Frame& F0, const ArgView& A) {
    FRAME_TID(F0);
    const GAS f32x4* g4 = (const GAS f32x4*)A.in(I_FINAL) + F.lane;
    f32x4 g[4];
#pragma unroll
    for (int j = 0; j < 4; ++j) g[j] = g4[64 * j];
    const bf16* hb = WSP(bf16, WS_HBA); float* out = A.out();
    const int rpw = M / F.G;
    auto rows = [&](auto UC, int m0) { constexpr int U = decltype(UC)::value;
        u32x2v w[U][4];
#pragma unroll
        for (int u = 0; u < U; ++u) { const GAS u32x2v* hr = (const GAS u32x2v*)(hb + (size_t)(m0 + u * NWAVES) * DMODEL) + F.lane;
#pragma unroll
            for (int j = 0; j < 4; ++j) w[u][j] = hr[64 * j]; }
#pragma unroll
        for (int u = 0; u < U; ++u) { const int m = m0 + u * NWAVES; f32x4 v[4]; float s = 0.f;
#pragma unroll
            for (int j = 0; j < 4; ++j) { v[j] = (f32x4){bflo(w[u][j].x), bfhi(w[u][j].x), bflo(w[u][j].y), bfhi(w[u][j].y)}; s += (v[j].x * v[j].x + v[j].y * v[j].y) + (v[j].z * v[j].z + v[j].w * v[j].w); }
            const float rs = 1.0f / sqrtf(wave_sum(s) * (1.0f / DMODEL) + NORM_EPS);
            GAS f32x4* xr = (GAS f32x4*)(out + (size_t)m * DMODEL) + F.lane;
#pragma unroll
            for (int j = 0; j < 4; ++j) xr[64 * j] = v[j] * rs * g[j]; } };
    const int mend = (F.vcu + 1) * rpw;
    int m = F.vcu * rpw + F.wave;
    for (; m + 3 * NWAVES < mend; m += 4 * NWAVES) rows(IntC<4>{}, m);
    for (; m < mend; m += NWAVES) rows(IntC<1>{}, m);
}

__device__ __forceinline__ f32x4 ldbf4(const bf16* p) { const u32x2v w = *(const GAS u32x2v*)p; return (f32x4){bflo(w.x), bfhi(w.x), bflo(w.y), bfhi(w.y)}; }
__device__ __forceinline__ f32x2v ldbf2(const bf16* p) { const unsigned w = *(const GAS unsigned*)p; return (f32x2v){bflo(w), bfhi(w)}; }
__device__ __forceinline__ void stbf4(bf16* p, const f32x4& o) { u32x2v w; w.x = cvt_pk_bf16(o[0], o[1]); w.y = cvt_pk_bf16(o[2], o[3]); *(GAS u32x2v*)p = w; }
__device__ __forceinline__ float dot4(const f32x4& a, const f32x4& b) { return (a[0] * b[0] + a[1] * b[1]) + (a[2] * b[2] + a[3] * b[3]); }
__device__ __forceinline__ void fixup_phase(const Frame& F0, const ArgView& A, int l) {
    FRAME_TID(F0);
    const float* halo = WSP(float, WS_HALO); bf16* act = WSP(bf16, WS_ACT);
    const float* cw = A.in(I_CONV_W) + (size_t)l * 3 * NUP; const float* cb = A.in(I_CONV_B) + (size_t)l * NUP;
    constexpr int NG4 = DFF / 4, NITEM = 64 * 2 * NG4;
    const f32x4 zero = (f32x4){0.f, 0.f, 0.f, 0.f};
    const int gsz = F.G / 8, bb = F.vcu / gsz, rk = F.vcu - bb * gsz;
    for (int it = bb * (NITEM / 8) + rk * NTHREADS + F.tid; it < (bb + 1) * (NITEM / 8); it += gsz * NTHREADS) {
        const int g4 = it % NG4, rw = it / NG4, pm = rw >> 1, last = rw & 1;
        const int c = 4 * g4, ucol = (c >> 7) * 256 + (c & 127);
        f32x4 u[2][3];
#pragma unroll
        for (int t = 0; t < 2; ++t) {
            const int uc = ucol + t * 128;
            if (!last) {
                u[t][0] = (pm & 7) ? *(const GAS f32x4*)(halo + ((size_t)(pm - 1) * 4 + 3) * NUP + uc) : zero;
                u[t][1] = *(const GAS f32x4*)(halo + ((size_t)pm * 4 + 0) * NUP + uc);
                u[t][2] = *(const GAS f32x4*)(halo + ((size_t)pm * 4 + 1) * NUP + uc);
            } else {
                u[t][0] = *(const GAS f32x4*)(halo + ((size_t)pm * 4 + 2) * NUP + uc);
                u[t][1] = *(const GAS f32x4*)(halo + ((size_t)pm * 4 + 3) * NUP + uc);
                u[t][2] = ((pm & 7) != 7) ? *(const GAS f32x4*)(halo + ((size_t)(pm + 1) * 4 + 0) * NUP + uc) : zero;
            }
        }
        f32x4 r[2];
#pragma unroll
        for (int t = 0; t < 2; ++t) { const int cc = t * DFF + c;
            r[t] = *(const GAS f32x4*)(cb + cc) + u[t][0] * *(const GAS f32x4*)(cw + cc) + u[t][1] * *(const GAS f32x4*)(cw + NUP + cc) + u[t][2] * *(const GAS f32x4*)(cw + 2 * NUP + cc); }
        f32x4 o;
#pragma unroll
        for (int e = 0; e < 4; ++e) { const float x = r[0][e]; const float z = x + 0.044715f * x * x * x;
            o[e] = x * fast_rcp(1.0f + fast_exp2(-2.0f * LOG2E * 0.7978845608028654f * z)) * r[1][e]; }
        stbf4(act + (size_t)(pm * 256 + (last ? 255 : 0)) * DFF + c, o);
    }
}

#define OSM_STEP(m, lsum, o, s, v) do { const float mn_ = fmaxf(m, s), f_ = fast_exp2(m - mn_), e_ = fast_exp2(s - mn_); o = o * f_ + v * e_; lsum = lsum * f_ + e_; m = mn_; } while (0)

__device__ __forceinline__ void naive_attn_phase(const Frame& F0, const ArgView& A, int l) {
    FRAME_TID(F0);
    bf16* QO = WSP(bf16, X_QO);
    const bf16 *KA = WSP(bf16, X_KA), *VA = WSP(bf16, X_VA), *KC = WSP(bf16, X_KC), *VC = WSP(bf16, X_VC), *KD = WSP(bf16, X_KD), *VD = WSP(bf16, X_VD);
    const bf16 *QB = WSP(bf16, X_QB), *KB = WSP(bf16, X_KB), *VB = WSP(bf16, X_VB);
    const int l16 = F.tid & 15, grp = F.tid >> 4;
    const float lam_init = 0.8f - 0.6f * expf(-0.3f * (float)l);
    float lam;
    { const float* lq1 = A.in(I_LQ1) + l * 32; const float* lk1 = A.in(I_LK1) + l * 32; const float* lq2 = A.in(I_LQ2) + l * 32; const float* lk2 = A.in(I_LK2) + l * 32;
      const float a = g16_sum(lq1[l16] * lk1[l16] + lq1[l16 + 16] * lk1[l16 + 16]), b = g16_sum(lq2[l16] * lk2[l16] + lq2[l16 + 16] * lk2[l16 + 16]);
      lam = expf(a) - expf(b) + lam_init; }
    const float* rpb = A.in(I_RPB) + (size_t)l * 4 * 15 * 31; const float* subln = A.in(I_SUBLN) + l * 64;
    const int NG = 4 * 4 * M;
    for (int g0 = F.vcu * 32; g0 < NG; g0 += F.G * 32) {
        const int g = g0 + grp, mixer = g / (4 * M), rem = g % (4 * M), h = rem / M, r = rem % M;
        const int pos = r & (SEQ - 1), base = r - pos;
        const f32x4 zero = (f32x4){0.f, 0.f, 0.f, 0.f};
        if (mixer == 0) {
            const f32x4 q = ldbf4(QO + (size_t)r * 1024 + h * 64 + l16 * 4);
            f32x4 acc = zero; float wsum = 0.f, gm = -1e30f;
            f32x4 op[3]; float lse[3];
#pragma unroll
            for (int p = 0; p < 3; ++p) {
                const int dil = (p == 0) ? 1 : (p == 1 ? 4 : 16), L = SEQ / dil, nq = pos / dil, rho = pos % dil;
                float m = -1e30f, ls = 0.f; f32x4 o = zero;
                for (int dl = -64; dl <= 64; ++dl) {
                    const int nk = nq + dl;
                    if (nk < 0 || nk >= L) continue;
                    const size_t kr = (size_t)(base + nk * dil + rho);
                    const float s = g16_sum(dot4(q, ldbf4(KA + kr * 256 + h * 64 + l16 * 4)));
                    const f32x4 v = ldbf4(VA + kr * 256 + h * 64 + l16 * 4);
                    OSM_STEP(m, ls, o, s, v);
                }
                op[p] = o * (1.0f / ls); lse[p] = m + __log2f(ls);
            }
            gm = fmaxf(lse[0], fmaxf(lse[1], lse[2]));
#pragma unroll
            for (int p = 0; p < 3; ++p) { const float w = fast_exp2(lse[p] - gm); acc = acc + op[p] * w; wsum += w; }
            stbf4(QO + (size_t)r * 1024 + h * 64 + l16 * 4, acc * (1.0f / wsum));
        } else if (mixer == 1) {
            const bf16* qp = QB + (size_t)r * 384 + h * 96 + l16 * 6;
            const f32x2v q0 = ldbf2(qp), q1 = ldbf2(qp + 2), q2 = ldbf2(qp + 4);
            float m = -1e30f, ls = 0.f; f32x4 o = zero;
            for (int j = 0; j < SEQ; ++j) {
                const bf16* kp = KB + (size_t)(base + j) * 384 + h * 96 + l16 * 6;
                const f32x2v k0 = ldbf2(kp), k1 = ldbf2(kp + 2), k2 = ldbf2(kp + 4);
                const float s = g16_sum((q0.x * k0.x + q0.y * k0.y) + (q1.x * k1.x + q1.y * k1.y) + (q2.x * k2.x + q2.y * k2.y));
                const f32x4 v = ldbf4(VB + (size_t)(base + j) * 256 + h * 64 + l16 * 4);
                OSM_STEP(m, ls, o, s, v);
            }
            stbf4(QO + (size_t)r * 1024 + 256 + h * 64 + l16 * 4, o * (1.0f / ls));
        } else if (mixer == 2) {
            const bf16* qp = QO + (size_t)r * 1024 + 512 + h * 64;
            const f32x2v q1 = ldbf2(qp + l16 * 2), q2 = ldbf2(qp + 32 + l16 * 2);
            float m1 = -1e30f, l1 = 0.f, m2 = -1e30f, l2 = 0.f; f32x4 o1 = zero, o2 = zero;
            for (int j = 0; j < SEQ; ++j) {
                const bf16* kp = KC + (size_t)(base + j) * 256 + h * 64;
                const f32x2v k1 = ldbf2(kp + l16 * 2), k2 = ldbf2(kp + 32 + l16 * 2);
                const float s1 = g16_sum(q1.x * k1.x + q1.y * k1.y), s2 = g16_sum(q2.x * k2.x + q2.y * k2.y);
                const f32x4 v = ldbf4(VC + (size_t)(base + j) * 256 + h * 64 + l16 * 4);
                OSM_STEP(m1, l1, o1, s1, v); OSM_STEP(m2, l2, o2, s2, v);
            }
            f32x4 o = o1 * (1.0f / l1) - o2 * (lam / l2);
            const float ss = g16_sum(dot4(o, o));
            const float rs = (1.0f - lam_init) / sqrtf(ss * (1.0f / 64.0f) + 1e-5f);
            const f32x4 gsub = *(const GAS f32x4*)(subln + l16 * 4);
            stbf4(QO + (size_t)r * 1024 + 512 + h * 64 + l16 * 4, o * gsub * rs);
        } else {
            const int gr = pos >> 6, gc = pos & 63;
            int rs_ = gr - 4; rs_ = rs_ < 0 ? 0 : (rs_ > 24 ? 24 : rs_);
            int cs_ = gc - 8; cs_ = cs_ < 0 ? 0 : (cs_ > 48 ? 48 : cs_);
            const f32x4 q = ldbf4(QO + (size_t)r * 1024 + 768 + h * 64 + l16 * 4);
            float m = -1e30f, ls = 0.f; f32x4 o = zero;
            for (int jr = 0; jr < 8; ++jr)
                for (int jc = 0; jc < 16; ++jc) {
                    const int kr_ = rs_ + jr, kc = cs_ + jc; const size_t krow = (size_t)(base + kr_ * 64 + kc);
                    const float s = g16_sum(dot4(q, ldbf4(KD + krow * 256 + h * 64 + l16 * 4))) + LOG2E * rpb[(h * 15 + (kr_ - gr + 7)) * 31 + (kc - gc + 15)];
                    const f32x4 v = ldbf4(VD + krow * 256 + h * 64 + l16 * 4);
                    OSM_STEP(m, ls, o, s, v);
                }
            stbf4(QO + (size_t)r * 1024 + 768 + h * 64 + l16 * 4, o * (1.0f / ls));
        }
    }
}

namespace att {
typedef short bf16x8 __attribute__((ext_vector_type(8)));
typedef short s16x4 __attribute__((ext_vector_type(4)));
typedef short v4i16_t __attribute__((ext_vector_type(4)));
typedef __attribute__((address_space(3))) const unsigned char* lds_cptr;
constexpr int K_SLOT = 12288, V_SLOT = 8192, NKS = 4, NVS = 3, LDS_K = 0, LDS_V = NKS * K_SLOT, LDS_RPB = LDS_V + NVS * V_SLOT, LDS_ATT_END = LDS_RPB + 2048;
constexpr float NEGB = -1e30f, FLOORM = -1e4f;
__device__ __forceinline__ int crow(int r, int hi) { return (r & 3) + 8 * (r >> 2) + 4 * hi; }
__device__ __forceinline__ s16x4 vtr(lds_cptr p) { return __builtin_bit_cast(s16x4, __builtin_amdgcn_ds_read_tr16_b64_v4i16((__attribute__((address_space(3))) v4i16_t*)p)); }
__device__ __forceinline__ float xhalf_max(float m) { auto rr = __builtin_amdgcn_permlane32_swap(__float_as_uint(m), __float_as_uint(m), false, false); return fmaxf(__uint_as_float(rr[0]), __uint_as_float(rr[1])); }
__device__ __forceinline__ float xhalf_sum(float m) { auto rr = __builtin_amdgcn_permlane32_swap(__float_as_uint(m), __float_as_uint(m), false, false); return __uint_as_float(rr[0]) + __uint_as_float(rr[1]); }

constexpr float THR = 8.0f;
struct SM { float mref, l; f32x16 negm; };

#define MX3(a, b, c) __builtin_fmaxf(__builtin_fmaxf((a), (b)), (c))
__device__ __forceinline__ float rowmax32(const f32x16& p0, const f32x16& p1) {
    float a = MX3(p0[0], p0[1], p1[0]), b = MX3(p0[2], p0[3], p1[1]); a = MX3(a, p1[2], p1[3]);
#pragma unroll
    for (int r = 4; r < 16; r += 4) { a = MX3(a, p0[r], p0[r + 1]); b = MX3(b, p0[r + 2], p0[r + 3]); a = MX3(a, p1[r], p1[r + 1]); b = MX3(b, p1[r + 2], p1[r + 3]); }
    return xhalf_max(__builtin_fmaxf(a, b));
}
__device__ __forceinline__ unsigned pk(float lo, float hi) { return cvt_pk_bf16(lo, hi); }
__device__ __forceinline__ bf16x8 packp(const f32x16& p, int b) {
    v4u w; w.x = pk(p[b], p[b + 1]); w.y = pk(p[b + 2], p[b + 3]); w.z = pk(p[b + 4], p[b + 5]); w.w = pk(p[b + 6], p[b + 7]); return __builtin_bit_cast(bf16x8, w);
}
__device__ __forceinline__ void scale_o(f32x16 (&o)[2], float a) {
#pragma unroll
    for (int d0 = 0; d0 < 2; ++d0)
#pragma unroll
        for (int r = 0; r < 16; ++r) o[d0][r] *= a;
}
template <bool ADJ_NEXT>
__device__ __forceinline__ void smx_tile(f32x16& p0, f32x16& p1, SM& s, f32x16 (&o)[2], bool fresh, f32x16& n0, f32x16& n1, bool have_next) {
    const float rm = rowmax32(p0, p1);
    if (fresh || __any(rm > THR)) {
        const float dl = fresh ? __builtin_fmaxf(rm, FLOORM) : __builtin_fmaxf(rm, 0.f);
        s.mref += dl;
#pragma unroll
        for (int r = 0; r < 16; ++r) { p0[r] -= dl; p1[r] -= dl; }
        if (ADJ_NEXT && have_next) {
#pragma unroll
            for (int r = 0; r < 16; ++r) { n0[r] -= dl; n1[r] -= dl; }
        }
#pragma unroll
        for (int r = 0; r < 16; ++r) s.negm[r] = -s.mref;
        if (!fresh) { const float al = fast_exp2(-dl); s.l *= al; scale_o(o, al); }
    }
    float sum = 0.f;
#pragma unroll
    for (int r = 0; r < 16; ++r) { p0[r] = fast_exp2(p0[r]); p1[r] = fast_exp2(p1[r]); sum += p0[r] + p1[r]; }
    s.l += sum;
}
__device__ __forceinline__ void pv_tile(f32x16 (&o)[2], lds_cptr vp, const f32x16& p0, const f32x16& p1) {
    const bf16x8 pa0 = packp(p0, 0), pa1 = packp(p0, 8), pa2 = packp(p1, 0), pa3 = packp(p1, 8);
#pragma unroll
    for (int d0 = 0; d0 < 2; ++d0) {
        s16x4 lo[4], hi[4];
#pragma unroll
        for (int ks = 0; ks < 4; ++ks) { lo[ks] = vtr(vp + d0 * 4096 + ks * 1024); hi[ks] = vtr(vp + d0 * 4096 + ks * 1024 + 512); }
        __builtin_amdgcn_sched_barrier(0);
#pragma unroll
        for (int ks = 0; ks < 4; ++ks) {
            const bf16x8 vf = (bf16x8){lo[ks][0], lo[ks][1], lo[ks][2], lo[ks][3], hi[ks][0], hi[ks][1], hi[ks][2], hi[ks][3]};
            o[d0] = __builtin_amdgcn_mfma_f32_32x32x16_bf16(vf, ks == 0 ? pa0 : ks == 1 ? pa1 : ks == 2 ? pa2 : pa3, o[d0], 0, 0, 0);
        }
    }
}
struct VH { s16x4 lo[4], hi[4]; };
__device__ __forceinline__ void pv_reads(VH& f, lds_cptr vp, int d0) {
#pragma unroll
    for (int ks = 0; ks < 4; ++ks) { f.lo[ks] = vtr(vp + d0 * 4096 + ks * 1024); f.hi[ks] = vtr(vp + d0 * 4096 + ks * 1024 + 512); }
}
__device__ __forceinline__ void pv_mfmas(f32x16& o, const VH& f, const bf16x8& pa0, const bf16x8& pa1, const bf16x8& pa2, const bf16x8& pa3) {
#pragma unroll
    for (int ks = 0; ks < 4; ++ks) {
        const bf16x8 vf = (bf16x8){f.lo[ks][0], f.lo[ks][1], f.lo[ks][2], f.lo[ks][3], f.hi[ks][0], f.hi[ks][1], f.hi[ks][2], f.hi[ks][3]};
        o = __builtin_amdgcn_mfma_f32_32x32x16_bf16(vf, ks == 0 ? pa0 : ks == 1 ? pa1 : ks == 2 ? pa2 : pa3, o, 0, 0, 0);
    }
}
__device__ __forceinline__ void store_o(bf16* orow, const f32x16 (&o)[2], float sc, int hi) {
#pragma unroll
    for (int d0 = 0; d0 < 2; ++d0)
#pragma unroll
        for (int gp = 0; gp < 2; ++gp) {
            const int ge = 2 * gp, go = ge + 1;
            const unsigned e0 = pk(o[d0][4 * ge] * sc, o[d0][4 * ge + 1] * sc), e1 = pk(o[d0][4 * ge + 2] * sc, o[d0][4 * ge + 3] * sc);
            const unsigned o0 = pk(o[d0][4 * go] * sc, o[d0][4 * go + 1] * sc), o1 = pk(o[d0][4 * go + 2] * sc, o[d0][4 * go + 3] * sc);
            auto s0 = __builtin_amdgcn_permlane32_swap(e0, o0, false, false); auto s1 = __builtin_amdgcn_permlane32_swap(e1, o1, false, false);
            v4u w; w.x = s0[0]; w.y = s1[0]; w.z = s0[1]; w.w = s1[1];
            *(GAS v4u*)(orow + 32 * d0 + 8 * (ge + hi)) = w; }
}

__device__ __forceinline__ void glds16(const void* gsrc, unsigned lds_dst) { unsigned keep;
    asm volatile("s_mov_b32 %0, m0\n\ts_mov_b32 m0, %2\n\ts_nop 0\n\tglobal_load_lds_dwordx4 %1, off\n\ts_mov_b32 m0, %0" : "=&s"(keep) : "v"(gsrc), "s"(lds_dst) : "memory"); }
template <int NCH> __device__ __forceinline__ void k_dma(const bf16* K, int kpitch, int krow_lane, unsigned lds0, int slot, int wave) {
#pragma unroll
    for (int i = 0; i < (NCH + 7) / 8; ++i) { const int c = wave + 8 * i; if (c < NCH) glds16(K + (size_t)krow_lane * kpitch + 8 * c, (unsigned)__builtin_amdgcn_readfirstlane(lds0 + LDS_K + slot * K_SLOT + c * 1024)); }
}
__device__ __forceinline__ void v_dma(const bf16* V, int vpitch, int vrow_lane, unsigned lds0, int slot, int wave, int lane) {
    glds16(V + (size_t)vrow_lane * vpitch + (wave >> 2) * 32 + (lane & 3) * 8, (unsigned)__builtin_amdgcn_readfirstlane(lds0 + LDS_V + slot * V_SLOT + wave * 1024));
}
__device__ __forceinline__ void wait_bar(int n) {
    switch (n) {
        case 0: asm volatile("s_waitcnt vmcnt(0)" ::: "memory"); break;
        case 1: asm volatile("s_waitcnt vmcnt(1)" ::: "memory"); break;
        case 2: asm volatile("s_waitcnt vmcnt(2)" ::: "memory"); break;
        case 3: asm volatile("s_waitcnt vmcnt(3)" ::: "memory"); break;
        case 4: asm volatile("s_waitcnt vmcnt(4)" ::: "memory"); break;
        default: asm volatile("s_waitcnt vmcnt(5)" ::: "memory"); break;
    }
    asm volatile("s_waitcnt lgkmcnt(0)" ::: "memory"); __builtin_amdgcn_s_barrier(); asm volatile("" ::: "memory");
}

template <int ND0> __device__ __forceinline__ void qk_tile(f32x16& p0, f32x16& p1, lds_cptr kb, const bf16x8* qr, const f32x16& negm) {
    constexpr int NB = (ND0 + 2) / 3, BS = (ND0 + NB - 1) / NB;
#pragma unroll
    for (int bt = 0; bt < NB; ++bt) {
        bf16x8 k0[BS], k1[BS];
#pragma unroll
        for (int i = 0; i < BS; ++i) { const int d0 = bt * BS + i; if (d0 < ND0) { k0[i] = *(const __attribute__((address_space(3))) bf16x8*)(kb + d0 * 2048); k1[i] = *(const __attribute__((address_space(3))) bf16x8*)(kb + d0 * 2048 + 512); } }
        __builtin_amdgcn_sched_barrier(0);
#pragma unroll
        for (int i = 0; i < BS; ++i) { const int d0 = bt * BS + i; if (d0 < ND0) {
            if (d0 == 0) { p0 = __builtin_amdgcn_mfma_f32_32x32x16_bf16(k0[i], qr[0], negm, 0, 0, 0); p1 = __builtin_amdgcn_mfma_f32_32x32x16_bf16(k1[i], qr[0], negm, 0, 0, 0); }
            else { p0 = __builtin_amdgcn_mfma_f32_32x32x16_bf16(k0[i], qr[d0], p0, 0, 0, 0); p1 = __builtin_amdgcn_mfma_f32_32x32x16_bf16(k1[i], qr[d0], p1, 0, 0, 0); } } }
    }
}

template <int ND0, class Pol>
__device__ __forceinline__ void attn_unit(const Pol& P, LAS unsigned char* lds, const bf16* Q, int qpitch, const bf16* K, int kpitch, const bf16* V, int vpitch,
                                          f32x16 (&o)[2], SM& st, int wave, int lane) {
    constexpr int NCH = 2 * ND0;
    const int r32 = lane & 31, hi = lane >> 5;
    const unsigned lds0 = (unsigned)(unsigned long)lds;
    const int nk = (wave < NCH ? 1 : 0) + (wave + 8 < NCH ? 1 : 0);
    const int nt = P.ntiles();
    const int vj = 16 * (wave & 3) + (lane >> 2);
    k_dma<NCH>(K, kpitch, P.key_row(0, lane), lds0, 0, wave); v_dma(V, vpitch, P.key_row(0, vj), lds0, 0, wave, lane);
    if (nt > 1) k_dma<NCH>(K, kpitch, P.key_row(1, lane), lds0, 1, wave);
    if (nt > 1) v_dma(V, vpitch, P.key_row(1, vj), lds0, 1, wave, lane);
    if (nt > 2) k_dma<NCH>(K, kpitch, P.key_row(2, lane), lds0, 2, wave);
    bf16x8 qr[ND0];
    { const bf16* qp = Q + (size_t)P.q_row(wave, r32) * qpitch;
#pragma unroll
      for (int d0 = 0; d0 < ND0; ++d0) qr[d0] = *(const GAS bf16x8*)(qp + d0 * 16 + hi * 8); }
    st.mref = 0.f; st.l = 0.f; st.negm = f32x16{}; o[0] = f32x16{}; o[1] = f32x16{};
#pragma unroll
    for (int d0 = 0; d0 < ND0; ++d0) asm volatile("" : "+v"(qr[d0]));
    wait_bar((nt > 1 ? 1 : 0) + (nt > 2 ? nk : 0));
    const lds_cptr l3 = (lds_cptr)lds;
    const lds_cptr kp0 = l3 + LDS_K + hi * 1024 + r32 * 16;
    const lds_cptr vp0 = l3 + LDS_V + ((lane >> 4) & 1) * 32 + (lane & 3) * 8 + (4 * hi + ((lane & 15) >> 2)) * 64;
    f32x16 a0, a1, b0, b1;
    a0 = f32x16{}; a1 = f32x16{}; b0 = f32x16{}; b1 = f32x16{};
    bool fresh = true;
    if (!P.skip(0, wave)) qk_tile<ND0>(a0, a1, kp0, qr, st.negm);
    int vs_cur = 0, vs_wr = 2;
#define ATT_ITER1(TT, C0, C1, N0, N1) do { const int ti_ = (TT); \
        const bool ik_ = ti_ + 3 < nt, iv_ = ti_ + 2 < nt; \
        if (ik_) k_dma<NCH>(K, kpitch, P.key_row(ti_ + 3, lane), lds0, (ti_ + 3) & 3, wave); \
        if (iv_) v_dma(V, vpitch, P.key_row(ti_ + 2, vj), lds0, vs_wr, wave, lane); \
        const bool dn_ = (ti_ + 1 < nt) && !P.skip(ti_ + 1, wave), dc_ = !P.skip(ti_, wave); \
        VH v0_, v1_; if (dc_) { pv_reads(v0_, vp0 + vs_cur * V_SLOT, 0); __builtin_amdgcn_sched_barrier(0); }     \
        if (dn_) qk_tile<ND0>(N0, N1, kp0 + ((ti_ + 1) & 3) * K_SLOT, qr, st.negm); \
        if (dc_) { P.mask(C0, C1, ti_, wave, r32, hi); smx_tile<true>(C0, C1, st, o, fresh, N0, N1, dn_); fresh = false; \
            const bf16x8 pa0_ = packp(C0, 0), pa1_ = packp(C0, 8), pa2_ = packp(C1, 0), pa3_ = packp(C1, 8); \
            pv_reads(v1_, vp0 + vs_cur * V_SLOT, 1); __builtin_amdgcn_sched_barrier(0); pv_mfmas(o[0], v0_, pa0_, pa1_, pa2_, pa3_); pv_mfmas(o[1], v1_, pa0_, pa1_, pa2_, pa3_); } \
        wait_bar((ik_ ? nk : 0) + (iv_ ? 1 : 0)); \
        vs_cur = (vs_cur == NVS - 1) ? 0 : vs_cur + 1; vs_wr = (vs_wr == NVS - 1) ? 0 : vs_wr + 1; } while (0)
    for (int t = 0; t < nt; t += 2) {
        ATT_ITER1(t, a0, a1, b0, b1);
        if (t + 1 < nt) ATT_ITER1(t + 1, b0, b1, a0, a1);
    }
#undef ATT_ITER1
}

template <class Pol>
__device__ __forceinline__ void attn_unit_c(const Pol& P, LAS unsigned char* lds, const bf16* Q, int qpitch, const bf16* K, int kpitch, const bf16* V, int vpitch,
                                            f32x16 (&o)[2][2], SM (&st)[2], int wave, int lane) {
    constexpr int NCH = 8, NR = 3;
    const int r32 = lane & 31, hi = lane >> 5;
    const unsigned lds0 = (unsigned)(unsigned long)lds;
    const int nt = P.ntiles();
    const int vj = 16 * (wave & 3) + (lane >> 2);
    k_dma<NCH>(K, kpitch, P.key_row(0, lane), lds0, 0, wave); v_dma(V, vpitch, P.key_row(0, vj), lds0, 0, wave, lane);
    if (nt > 1) { k_dma<NCH>(K, kpitch, P.key_row(1, lane), lds0, 1, wave); v_dma(V, vpitch, P.key_row(1, vj), lds0, 1, wave, lane); }
    bf16x8 qr[2][2];
    { const bf16* qp = Q + (size_t)P.q_row(wave, r32) * qpitch;
#pragma unroll
      for (int mp = 0; mp < 2; ++mp)
#pragma unroll
          for (int d0 = 0; d0 < 2; ++d0) qr[mp][d0] = *(const GAS bf16x8*)(qp + mp * 32 + d0 * 16 + hi * 8); }
#pragma unroll
    for (int mp = 0; mp < 2; ++mp) { st[mp].mref = 0.f; st[mp].l = 0.f; st[mp].negm = f32x16{}; o[mp][0] = f32x16{}; o[mp][1] = f32x16{}; }
#pragma unroll
    for (int mp = 0; mp < 2; ++mp)
#pragma unroll
        for (int d0 = 0; d0 < 2; ++d0) asm volatile("" : "+v"(qr[mp][d0]));
    wait_bar(nt > 1 ? 2 : 0);
    const lds_cptr l3 = (lds_cptr)lds;
    const lds_cptr kp0 = l3 + LDS_K + hi * 1024 + r32 * 16;
    const lds_cptr vp0 = l3 + LDS_V + ((lane >> 4) & 1) * 32 + (lane & 3) * 8 + (4 * hi + ((lane & 15) >> 2)) * 64;
    bool fresh = true;
    int sc = 0, sw = 2;
    for (int t = 0; t < nt; ++t) {
        const bool is2 = t + 2 < nt;
        if (is2) { k_dma<NCH>(K, kpitch, P.key_row(t + 2, lane), lds0, sw, wave); v_dma(V, vpitch, P.key_row(t + 2, vj), lds0, sw, wave, lane); }
        VH v0_, v1_; pv_reads(v0_, vp0 + sc * V_SLOT, 0); __builtin_amdgcn_sched_barrier(0);
#pragma unroll
        for (int mp = 0; mp < 2; ++mp) {
            f32x16 p0, p1;
            qk_tile<2>(p0, p1, kp0 + sc * K_SLOT + mp * 4096, qr[mp], st[mp].negm);
            if (mp == 0) { pv_reads(v1_, vp0 + sc * V_SLOT, 1); __builtin_amdgcn_sched_barrier(0); }
            smx_tile<false>(p0, p1, st[mp], o[mp], fresh, p0, p1, false);
            const bf16x8 pa0_ = packp(p0, 0), pa1_ = packp(p0, 8), pa2_ = packp(p1, 0), pa3_ = packp(p1, 8);
            pv_mfmas(o[mp][0], v0_, pa0_, pa1_, pa2_, pa3_); pv_mfmas(o[mp][1], v1_, pa0_, pa1_, pa2_, pa3_);
        }
        fresh = false;
        wait_bar(is2 ? 2 : 0);
        sc = (sc == NR - 1) ? 0 : sc + 1; sw = (sw == NR - 1) ? 0 : sw + 1;
    }
}

struct PolDense {
    int base, q0;
    __device__ __forceinline__ int ntiles() const { return SEQ / 64; }
    __device__ __forceinline__ int key_row(int t, int j) const { return base + 64 * t + j; }
    __device__ __forceinline__ bool skip(int, int) const { return false; }
    __device__ __forceinline__ void mask(f32x16&, f32x16&, int, int, int, int) const {}
    __device__ __forceinline__ int q_row(int wave, int r32) const { return q0 + 32 * wave + r32; }
};
struct PolBand {
    int gbase0, gstep, dil, L, nk0, tpg, nt, nq0w, wgrp;
    __device__ __forceinline__ int ntiles() const { return nt; }
    __device__ __forceinline__ int key_row(int t, int j) const { const int g = t / tpg; int nk = nk0 + 64 * (t - g * tpg) + j; nk = nk < 0 ? 0 : (nk > L - 1 ? L - 1 : nk); return gbase0 + g * gstep + nk * dil; }
    __device__ __forceinline__ bool skip(int t, int) const { const int g = t / tpg, k0 = nk0 + 64 * (t - g * tpg); return g != wgrp || k0 + 63 < nq0w - 64 || k0 > nq0w + 31 + 64 || k0 + 63 < 0 || k0 >= L; }
    __device__ __forceinline__ void mask(f32x16& p0, f32x16& p1, int t, int, int r32, int hi) const {
        const int g = t / tpg, k0 = nk0 + 64 * (t - g * tpg), nq = nq0w + r32;
#pragma unroll
        for (int r = 0; r < 16; ++r) { const int nk = k0 + crow(r, hi), d0 = nk - nq, nk1 = nk + 32, d1 = nk1 - nq;
            if (!((unsigned)nk < (unsigned)L && d0 >= -64 && d0 <= 64)) p0[r] = NEGB;
            if (!((unsigned)nk1 < (unsigned)L && d1 >= -64 && d1 <= 64)) p1[r] = NEGB; }
    }
    __device__ __forceinline__ int q_row(int, int r32) const { return gbase0 + wgrp * gstep + (nq0w + r32) * dil; }
};
struct PolNA {
    int base, kr0, nt, R, cb; const LAS float* rpb;
    __device__ __forceinline__ int ntiles() const { return nt; }
    __device__ __forceinline__ int key_row(int t, int j) const { return base + (kr0 + t) * 64 + j; }
    __device__ __forceinline__ int kstart() const { const int s = R - 4; return s < 0 ? 0 : (s > 24 ? 24 : s); }
    __device__ __forceinline__ bool skip(int t, int) const { const int kr = kr0 + t, ks = kstart(); return kr < ks || kr >= ks + 8; }
    __device__ __forceinline__ void mask(f32x16& p0, f32x16& p1, int t, int, int r32, int hi) const {
        const int qc = cb + r32; int cs = qc - 8; cs = cs < 0 ? 0 : (cs > 48 ? 48 : cs);
        const LAS float* row = rpb + (kr0 + t - R + 7) * 31 + 15 - qc;
#pragma unroll
        for (int g = 0; g < 4; ++g) {
#pragma unroll
            for (int e = 0; e < 4; ++e) { const int r = 4 * g + e, kc = crow(r, hi), kc1 = kc + 32;
                const bool ok0 = (unsigned)(kc - cs) < 16u, ok1 = (unsigned)(kc1 - cs) < 16u;
                const float b0 = row[kc], b1 = row[kc1];
                p0[r] = ok0 ? p0[r] + b0 : NEGB; p1[r] = ok1 ? p1[r] + b1 : NEGB; }
            asm volatile("" ::: "memory");
        }
    }
    __device__ __forceinline__ int q_row(int, int r32) const { return base + R * 64 + cb + r32; }
};

template <class Pol>
__device__ __forceinline__ void attn_wave_unit(const Pol& P, LAS unsigned char* wlds, const bf16* Q, int qpitch, const bf16* K, int kpitch, const bf16* V, int vpitch,
                                               f32x16 (&o)[2], SM& st, int lane) {
    const int r32 = lane & 31, hi = lane >> 5;
    const unsigned lds0 = (unsigned)(unsigned long)wlds;
    bf16x8 qr[4];
    { const bf16* qp = Q + (size_t)P.q_row(r32) * qpitch;
#pragma unroll
      for (int d0 = 0; d0 < 4; ++d0) qr[d0] = *(const GAS bf16x8*)(qp + d0 * 16 + hi * 8); }
    st.mref = 0.f; st.l = 0.f; st.negm = f32x16{}; o[0] = f32x16{}; o[1] = f32x16{};
#pragma unroll
    for (int d0 = 0; d0 < 4; ++d0) asm volatile("" : "+v"(qr[d0]));
    const lds_cptr kp0 = (lds_cptr)wlds + r32 * 128;
    const lds_cptr vp0 = (lds_cptr)wlds + 8192 + ((lane >> 4) & 1) * 32 + (lane & 3) * 8 + (4 * hi + ((lane & 15) >> 2)) * 64;
    const int krow = lane >> 3, kslot = lane & 7;
    bool fresh = true;
    const int nt = P.ntiles();
    for (int tt = 0; tt < nt; ++tt) {
        if (P.skip(tt)) continue;
        asm volatile("s_waitcnt lgkmcnt(0)" ::: "memory");
#pragma unroll
        for (int i = 0; i < 8; ++i) { const int row = 8 * i + krow;
            glds16(K + (size_t)P.key_row(tt, row) * kpitch + ((kslot ^ (row & 7)) * 8), (unsigned)__builtin_amdgcn_readfirstlane(lds0 + i * 1024)); }
#pragma unroll
        for (int p = 0; p < 8; ++p) glds16(V + (size_t)P.key_row(tt, 16 * (p & 3) + (lane >> 2)) * vpitch + (p >> 2) * 32 + (lane & 3) * 8, (unsigned)__builtin_amdgcn_readfirstlane(lds0 + 8192 + p * 1024));
        asm volatile("s_waitcnt vmcnt(8)" ::: "memory");
        f32x16 p0, p1;
#pragma unroll
        for (int d0 = 0; d0 < 4; ++d0) {
            const int sw = ((2 * d0 + hi) ^ (r32 & 7)) * 16;
            const bf16x8 k0 = *(const __attribute__((address_space(3))) bf16x8*)(kp0 + sw), k1 = *(const __attribute__((address_space(3))) bf16x8*)(kp0 + 4096 + sw);
            if (d0 == 0) { p0 = __builtin_amdgcn_mfma_f32_32x32x16_bf16(k0, qr[0], st.negm, 0, 0, 0); p1 = __builtin_amdgcn_mfma_f32_32x32x16_bf16(k1, qr[0], st.negm, 0, 0, 0); }
            else { p0 = __builtin_amdgcn_mfma_f32_32x32x16_bf16(k0, qr[d0], p0, 0, 0, 0); p1 = __builtin_amdgcn_mfma_f32_32x32x16_bf16(k1, qr[d0], p1, 0, 0, 0); }
        }
        P.mask(p0, p1, tt, r32, hi);
        smx_tile<false>(p0, p1, st, o, fresh, p0, p1, false); fresh = false;
        asm volatile("s_waitcnt vmcnt(0)" ::: "memory");
        pv_tile(o, vp0, p0, p1);
    }
    asm volatile("s_waitcnt lgkmcnt(0)" ::: "memory");
}
struct PolBandW {
    int gbase, dil, L, nq0;
    __device__ __forceinline__ int ntiles() const { return 3; }
    __device__ __forceinline__ int key_row(int tt, int j) const { int nk = nq0 - 64 + 64 * tt + j; nk = nk < 0 ? 0 : (nk > L - 1 ? L - 1 : nk); return gbase + nk * dil; }
    __device__ __forceinline__ bool skip(int tt) const { const int k0 = nq0 - 64 + 64 * tt; return k0 + 63 < 0 || k0 >= L; }
    __device__ __forceinline__ void mask(f32x16& p0, f32x16& p1, int tt, int r32, int hi) const {
        const int k0 = nq0 - 64 + 64 * tt, dq = 64 - 64 * tt + r32;
        int lo = dq - 64; lo = lo > -k0 ? lo : -k0; int up = dq + 64; up = up < L - 1 - k0 ? up : L - 1 - k0;
        if (__all(lo <= 0 && up >= 63)) return;
        const unsigned span = up >= lo ? (unsigned)(up - lo) : 0u; const int lo2 = (up >= lo ? lo : 4096) - 4 * hi;
#pragma unroll
        for (int r = 0; r < 16; ++r) { const int c = (r & 3) + 8 * (r >> 2);
            if ((unsigned)(c - lo2) > span) p0[r] = NEGB;
            if ((unsigned)(c + 32 - lo2) > span) p1[r] = NEGB; }
    }
    __device__ __forceinline__ int q_row(int r32) const { return gbase + (nq0 + r32) * dil; }
};
struct PolBandR {
    int gbase0, gstep, dil, L, nk0, tpg, ntl, wgrp, nq0, t0, ntw;
    __device__ __forceinline__ int key_row(int t, int j) const { const int g = t / tpg; int nk = nk0 + 64 * (t - g * tpg) + j; nk = nk < 0 ? 0 : (nk > L - 1 ? L - 1 : nk); return gbase0 + g * gstep + nk * dil; }
    __device__ __forceinline__ int tile_k0(int t) const { const int g = t / tpg; return nk0 + 64 * (t - g * tpg); }
    __device__ __forceinline__ int q_row(int r32) const { return gbase0 + wgrp * gstep + (nq0 + r32) * dil; }
};
__device__ __forceinline__ void band_mask(f32x16& p0, f32x16& p1, int k0, int nq0, int L, int r32, int hi) {
    const int dq = nq0 + r32 - k0;
    int lo = dq - 64; lo = lo > -k0 ? lo : -k0; int up = dq + 64; up = up < L - 1 - k0 ? up : L - 1 - k0;
    if (__all(lo <= 0 && up >= 63)) return;
    const unsigned span = up >= lo ? (unsigned)(up - lo) : 0u; const int lo2 = (up >= lo ? lo : 4096) - 4 * hi;
#pragma unroll
    for (int r = 0; r < 16; ++r) { const int c = (r & 3) + 8 * (r >> 2);
        if ((unsigned)(c - lo2) > span) p0[r] = NEGB;
        if ((unsigned)(c + 32 - lo2) > span) p1[r] = NEGB; }
}
__device__ __forceinline__ void attn_resident_unit(const PolBandR& P, LAS unsigned char* lds, const bf16* Q, int qpitch, const bf16* K, int kpitch, const bf16* V, int vpitch,
                                                   f32x16 (&o)[2], SM& st, int wave, int lane) {
    const int r32 = lane & 31, hi = lane >> 5;
    const unsigned lds0 = (unsigned)(unsigned long)lds;
    const int krow = 8 * wave + (lane >> 3), kslot = lane & 7;
    for (int t = 0; t < P.ntl; ++t) {
        glds16(K + (size_t)P.key_row(t, krow) * kpitch + ((kslot ^ (krow & 7)) * 8), (unsigned)__builtin_amdgcn_readfirstlane(lds0 + t * 16384 + wave * 1024));
        glds16(V + (size_t)P.key_row(t, 16 * (wave & 3) + (lane >> 2)) * vpitch + (wave >> 2) * 32 + (lane & 3) * 8, (unsigned)__builtin_amdgcn_readfirstlane(lds0 + t * 16384 + 8192 + wave * 1024));
    }
    bf16x8 qr[4];
    { const bf16* qp = Q + (size_t)P.q_row(r32) * qpitch;
#pragma unroll
      for (int d0 = 0; d0 < 4; ++d0) qr[d0] = *(const GAS bf16x8*)(qp + d0 * 16 + hi * 8); }
    st.mref = 0.f; st.l = 0.f; st.negm = f32x16{}; o[0] = f32x16{}; o[1] = f32x16{};
#pragma unroll
    for (int d0 = 0; d0 < 4; ++d0) asm volatile("" : "+v"(qr[d0]));
    wait_bar(0);
    bool fresh = true;
    for (int i = 0; i < P.ntw; ++i) {
        const int t = P.t0 + i, k0 = P.tile_k0(t);
        if (k0 + 63 < 0 || k0 >= P.L) continue;
        const lds_cptr kp0 = (lds_cptr)lds + t * 16384 + r32 * 128;
        const lds_cptr vp0 = (lds_cptr)lds + t * 16384 + 8192 + ((lane >> 4) & 1) * 32 + (lane & 3) * 8 + (4 * hi + ((lane & 15) >> 2)) * 64;
        f32x16 p0, p1;
        bf16x8 k0f[4], k1f[4];
#pragma unroll
        for (int d0 = 0; d0 < 4; ++d0) { const int sw = ((2 * d0 + hi) ^ (r32 & 7)) * 16;
            k0f[d0] = *(const __attribute__((address_space(3))) bf16x8*)(kp0 + sw); k1f[d0] = *(const __attribute__((address_space(3))) bf16x8*)(kp0 + 4096 + sw); }
        __builtin_amdgcn_sched_barrier(0);
#pragma unroll
        for (int d0 = 0; d0 < 4; ++d0) {
            if (d0 == 0) { p0 = __builtin_amdgcn_mfma_f32_32x32x16_bf16(k0f[0], qr[0], st.negm, 0, 0, 0); p1 = __builtin_amdgcn_mfma_f32_32x32x16_bf16(k1f[0], qr[0], st.negm, 0, 0, 0); }
            else { p0 = __builtin_amdgcn_mfma_f32_32x32x16_bf16(k0f[d0], qr[d0], p0, 0, 0, 0); p1 = __builtin_amdgcn_mfma_f32_32x32x16_bf16(k1f[d0], qr[d0], p1, 0, 0, 0); }
        }
        band_mask(p0, p1, k0, P.nq0, P.L, r32, hi);
        smx_tile<false>(p0, p1, st, o, fresh, p0, p1, false); fresh = false;
        pv_tile(o, vp0, p0, p1);
    }
    wait_bar(0);
}
struct PolNAW {
    int base, R, cb, ks; const LAS float* rpb;
    f32x16 am0, am1;
    __device__ __forceinline__ void init_mask(int r32, int hi) {
        const int qc = cb + r32; int cs = qc - 8; cs = cs < 0 ? 0 : (cs > 48 ? 48 : cs);
#pragma unroll
        for (int r = 0; r < 16; ++r) { const int kc = crow(r, hi); am0[r] = ((unsigned)(kc - cs) < 16u) ? 0.f : NEGB; am1[r] = ((unsigned)(kc + 32 - cs) < 16u) ? 0.f : NEGB; }
    }
    __device__ __forceinline__ int ntiles() const { return 8; }
    __device__ __forceinline__ int key_row(int tt, int j) const { return base + (ks + tt) * 64 + j; }
    __device__ __forceinline__ bool skip(int) const { return false; }
    __device__ __forceinline__ void mask(f32x16& p0, f32x16& p1, int tt, int r32, int hi) const {
        const int qc = cb + r32;
        const LAS float* row = rpb + (ks + tt - R + 7) * 31 + 15 - qc + 4 * hi;
#pragma unroll
        for (int r = 0; r < 16; ++r) { const int c = (r & 3) + 8 * (r >> 2);
            p0[r] = (p0[r] + row[c]) + am0[r]; p1[r] = (p1[r] + row[c + 32]) + am1[r]; }
    }
    __device__ __forceinline__ int q_row(int r32) const { return base + R * 64 + cb + r32; }
};
}

__device__ __forceinline__ void attn_a_phase(const Frame& F0, const ArgView& A, int l) {
    FRAME_TID(F0);
    using namespace att;
    constexpr bool dummy = false;
    const bf16* QO = WSP(bf16, X_QO);
    bf16* OAw = (bf16*)A.out(); float* LSEw = (float*)((unsigned char*)A.out() + 24 * MiB);
    const int wave = F.wave, lane = F.lane, r32 = lane & 31, hi = lane >> 5;
    const int bh = F.vcu >> 3, sub = F.vcu & 7, b = bh >> 2, h = bh & 3, base = b * SEQ;
    LAS unsigned char* lds = F.lds;
    for (int p = 0; p < 3; ++p) {
        PolBandR P;
        if (p == 0) { P.gbase0 = base; P.gstep = 0; P.dil = 1; P.L = SEQ; P.nk0 = 256 * sub - 64; P.tpg = 6; P.ntl = 6; P.wgrp = 0; P.nq0 = 256 * sub + 32 * wave; P.t0 = wave >> 1; P.ntw = 3; }
        else if (p == 1) { P.gbase0 = base + (sub >> 1); P.gstep = 0; P.dil = 4; P.L = SEQ / 4; P.nk0 = 256 * (sub & 1) - 64; P.tpg = 6; P.ntl = 6; P.wgrp = 0; P.nq0 = 256 * (sub & 1) + 32 * wave; P.t0 = wave >> 1; P.ntw = 3; }
        else { P.gbase0 = base + 2 * sub; P.gstep = 1; P.dil = 16; P.L = SEQ / 16; P.nk0 = 0; P.tpg = 2; P.ntl = 4; P.wgrp = wave >> 2; P.nq0 = 32 * (wave & 3); P.t0 = 2 * (wave >> 2); P.ntw = 2; }
        f32x16 o[2]; SM st;
        attn_resident_unit(P, lds, QO + h * 64, 1024, WSP(bf16, X_KA) + h * 64, 256, WSP(bf16, X_VA) + h * 64, 256, o, st, wave, lane);
        const float lt = xhalf_sum(st.l); const int qrow = P.q_row(r32);
        store_o(OAw + ((size_t)p * M + qrow) * 256 + h * 64, o, fast_rcp(lt), hi);
        if (hi == 0) LSEw[((size_t)p * M + qrow) * 4 + h] = st.mref + __log2f(lt);
    }
}

__device__ __forceinline__ void combine_phase(const Frame& F0, const ArgView& A, int l) {
    FRAME_TID(F0);
    bf16* QO = WSP(bf16, X_QO); const bf16* OA = (const bf16*)A.out(); const float* LSE = (const float*)((unsigned char*)A.out() + 24 * MiB);
    const int l16 = F.tid & 15, grp = F.tid >> 4;
    const int gpw = 4 * M / F.G;
    for (int g0 = F.vcu * gpw; g0 < (F.vcu + 1) * gpw; g0 += 32) {
        const int g = g0 + grp, r = g >> 2, h = g & 3;
        const float l0 = LSE[((size_t)0 * M + r) * 4 + h], l1 = LSE[((size_t)1 * M + r) * 4 + h], l2 = LSE[((size_t)2 * M + r) * 4 + h];
        const float mx = fmaxf(l0, fmaxf(l1, l2)), w0 = fast_exp2(l0 - mx), w1 = fast_exp2(l1 - mx), w2 = fast_exp2(l2 - mx), iw = fast_rcp(w0 + w1 + w2);
        const f32x4 a = ldbf4(OA + ((size_t)0 * M + r) * 256 + h * 64 + l16 * 4), b = ldbf4(OA + ((size_t)1 * M + r) * 256 + h * 64 + l16 * 4), c = ldbf4(OA + ((size_t)2 * M + r) * 256 + h * 64 + l16 * 4);
        stbf4(QO + (size_t)r * 1024 + h * 64 + l16 * 4, (a * w0 + b * w1 + c * w2) * iw);
    }
    {
        const float* p = A.in(I_P) + (size_t)l * M * PLE; bf16* pb = WSP(bf16, WS_PB);
        const int ipw = M * PLE / 8 / F.G;
        for (int i = F.vcu * ipw + F.tid; i < (F.vcu + 1) * ipw; i += NTHREADS) {
            const f32x4 a = *(const GAS f32x4*)(p + (size_t)i * 8), b = *(const GAS f32x4*)(p + (size_t)i * 8 + 4);
            v4u o; o.x = pk2(a.x, a.y); o.y = pk2(a.z, a.w); o.z = pk2(b.x, b.y); o.w = pk2(b.z, b.w);
            *(GAS v4u*)(pb + (size_t)i * 8) = o;
        }
    }
}

__device__ __forceinline__ void attn_phase(const Frame& F0, const ArgView& A, int l, bool dummy, bool gm, const XcdBarrier& bar, unsigned gx) {
    FRAME_TID(F0);
    using namespace att;
    const bf16* QO = WSP(bf16, X_QO); bf16* QOw = dummy ? WSP(bf16, WS_HBB) : WSP(bf16, X_QO);
    bf16* OAw = (bf16*)A.out(); float* LSEw = (float*)((unsigned char*)A.out() + 24 * MiB);
    const int wave = F.wave, lane = F.lane, r32 = lane & 31, hi = lane >> 5;
    const int bh = F.vcu >> 3, sub = F.vcu & 7, b = bh >> 2, h = bh & 3, base = b * SEQ;
    LAS unsigned char* lds = F.lds;
    if (!gm) combine_phase(F0, A, l);
#ifndef PROBE_SEL
#define PROBE_SEL 15
#endif
    LAS unsigned char* wlds = lds + wave * 16384;
    LAS float* rp = (LAS float*)(lds + XL_OFF);
    {
        const float* rpb = A.in(I_RPB) + ((size_t)l * 4 + h) * 15 * 31;
        for (int i = F.tid; i < 15 * 31; i += NTHREADS) rp[i] = rpb[i] * LOG2E;
        __syncthreads();
    }
    if (!dummy || (PROBE_SEL & 8)) {
        PolNAW P; P.base = base; P.R = 4 * sub + (wave >> 1); P.cb = 32 * (wave & 1); P.rpb = rp;
        { int s0 = P.R - 4; P.ks = s0 < 0 ? 0 : (s0 > 24 ? 24 : s0); }
        P.init_mask(r32, hi);
        f32x16 o[2]; SM st;
        attn_wave_unit<PolNAW>(P, wlds, QO + 768 + h * 64, 1024, WSP(bf16, X_KD) + h * 64, 256, WSP(bf16, X_VD) + h * 64, 256, o, st, lane);
        store_o(QOw + (size_t)P.q_row(r32) * 1024 + 768 + h * 64, o, fast_rcp(xhalf_sum(st.l)), hi);
    }
    __syncthreads();
    if (gm) grp_wait(bar, gx, 0u, 32u * (unsigned)(l + 1));
    if (!dummy || (PROBE_SEL & 2)) {
        PolDense P; P.base = base; P.q0 = base + 256 * sub;
        f32x16 o[2]; SM st;
        attn_unit<6, PolDense>(P, lds, WSP(bf16, X_QB) + h * 96, 384, WSP(bf16, X_KB) + h * 96, 384, WSP(bf16, X_VB) + h * 64, 256, o, st, wave, lane);
        store_o(QOw + (size_t)P.q_row(wave, r32) * 1024 + 256 + h * 64, o, fast_rcp(xhalf_sum(st.l)), hi);
    }
    if (!dummy || (PROBE_SEL & 4)) {
        float c08 = 0.8f, c06 = 0.6f; asm volatile("" : "+s"(c08), "+s"(c06));
        const float lam_init = c08 - c06 * fast_exp2(-0.3f * LOG2E * (float)l);
        float lam;
        { const float* lq1 = A.in(I_LQ1) + l * 32; const float* lk1 = A.in(I_LK1) + l * 32; const float* lq2 = A.in(I_LQ2) + l * 32; const float* lk2 = A.in(I_LK2) + l * 32;
          const float a = wave_sum(lane < 32 ? lq1[r32] * lk1[r32] : 0.f), bb = wave_sum(lane < 32 ? lq2[r32] * lk2[r32] : 0.f);
          lam = fast_exp2(a * LOG2E) - fast_exp2(bb * LOG2E) + lam_init; }
        PolDense P; P.base = base; P.q0 = base + 256 * sub;
        f32x16 o[2][2]; SM st[2]; float lsum[2];
        attn_unit_c<PolDense>(P, lds, QO + 512 + h * 64, 1024, WSP(bf16, X_KC) + h * 64, 256, WSP(bf16, X_VC) + h * 64, 256, o, st, wave, lane);
        lsum[0] = st[0].l; lsum[1] = st[1].l;
        const float i1 = fast_rcp(xhalf_sum(lsum[0])), i2 = lam * fast_rcp(xhalf_sum(lsum[1]));
        float ss = 0.f;
#pragma unroll
        for (int d0 = 0; d0 < 2; ++d0)
#pragma unroll
            for (int r = 0; r < 16; ++r) { const float v = o[0][d0][r] * i1 - o[1][d0][r] * i2; o[0][d0][r] = v; ss += v * v; }
        ss = xhalf_sum(ss);
        const float rs = (1.0f - lam_init) / sqrtf(ss * (1.0f / 64.0f) + 1e-5f);
        const float* subln = A.in(I_SUBLN) + l * 64;
#pragma unroll
        for (int d0 = 0; d0 < 2; ++d0)
#pragma unroll
            for (int g = 0; g < 4; ++g) { const f32x4 gs = *(const GAS f32x4*)(subln + 32 * d0 + 8 * g + 4 * hi);
#pragma unroll
                for (int e = 0; e < 4; ++e) o[0][d0][4 * g + e] *= gs[e]; }
        store_o(QOw + (size_t)P.q_row(wave, r32) * 1024 + 512 + h * 64, o[0], rs, hi);
    }
    if (gm) { grp_wait(bar, gx, 1u, 32u * (unsigned)(l + 1)); combine_phase(F0, A, l); }
}


#ifndef PHASE_MASK
#define PHASE_MASK 0x7ff
#endif
#define PH_ON(k) (((PHASE_MASK) >> (k)) & 1)
__global__ void __launch_bounds__(NTHREADS, 2) fwd_kernel(Args A) {
    extern __shared__ __attribute__((aligned(16))) unsigned char lds[];
    Frame F;
    F.lds = (LAS unsigned char*)lds;
    F.tid = threadIdx.x; F.lane = F.tid & 63; F.wave = __builtin_amdgcn_readfirstlane(F.tid >> 6);
    F.G = gridDim.x; { const int bx = blockIdx.x; F.vcu = (F.G % 8 == 0) ? (bx % 8) * (F.G / 8) + bx / 8 : bx; }
    F.ws = A.ws;
    volatile LAS unsigned* MISC = (volatile LAS unsigned*)(F.lds + MISC_OFF);
    for (int u = F.tid; u < (LDS_BYTES - LDSCTL_OFF) / 4; u += NTHREADS) ((LAS unsigned*)(F.lds + LDSCTL_OFF))[u] = 0u;
    __syncthreads();
    XcdBarrier bar; bar.wave = F.wave; bar.bar = (unsigned*)(A.ws + WS_CTL) + CW_BAR; bar.x = 0; bar.st = nullptr;
    if (MK_SINGLE) bar = xcd_barrier_post((unsigned*)(A.ws + WS_CTL) + CW_BAR, MISC + 8, F.wave);
    LAS unsigned char* ring = F.lds;
    F.tid = 0; F.lane = 0;
    int c = (int)blockIdx.x; const int G = F.G; const int vcu0 = F.vcu, wave0 = F.wave; unsigned char* const ws0 = A.ws; const int ph_lo = A.ph_lo, ph_hi = A.ph_hi;

    for (int ph = ph_lo; ph < ph_hi; ++ph) {
#ifdef PROBE_DUP
        constexpr int SPL = PH_PER_LAYER + 1;
        int l = (ph - 1) / SPL; const int j_ = (ph - 1) - l * SPL; const int k = (ph == 0) ? -1 : ((j_ <= PROBE_DUP) ? j_ : j_ - 1); const bool dry = (ph > 0 && j_ == PROBE_DUP);
        const bool is_final = (ph == DEPTH * SPL + 1);
#else
        int l = (ph - 1) / PH_PER_LAYER; const int k = (ph == 0) ? -1 : (ph - 1) - l * PH_PER_LAYER; constexpr bool dry = false; const bool is_final = (ph == N_PHASES - 1);
#endif
        ArgView AV; AV.kp = (const __attribute__((address_space(4))) unsigned char*)__builtin_amdgcn_kernarg_segment_ptr(); asm volatile("" : "+s"(AV.kp));
        { int c_ = (int)blockIdx.x; unsigned char* w_ = ws0; int v_ = vcu0, wv_ = wave0; asm volatile("" : "+s"(c_), "+s"(w_), "+s"(v_), "+s"(wv_), "+s"(l));
          c = c_; F.ws = w_; F.vcu = v_; F.wave = wv_; }
        unsigned char* const wl = F.ws + WS_W + (size_t)l * W_STRIDE;
        if (is_final) { if (PH_ON(10)) final_phase(F, AV); }
        else switch (k) {
        case -1: if (PH_ON(9)) prologue_phase(F, AV); break;
        case 0: if (PH_ON(0)) {
            pg8::Gemm g{WSP(pg8::bf16_t, WS_HBA), (pg8::bf16_t*)(wl + W_1T), M, N1, 1024}; pg8::StaticOrder S; S.init(M, N1, G, c);
            epi::EpiIn E{F.ws, (PG8_LAS float*)(F.lds + RSL_OFF)};
            pg8::gemm_phase<epi::EpiIn, pg8::StaticOrder, true, true>(ring, g, S, E, F.wave);
        } break;
        case 1: if (PH_ON(1)) {
            const int half = G / 2; const bool uq = c < half;
            pg8::Gemm g; g.A = uq ? WSP(pg8::bf16_t, X_CQ) : WSP(pg8::bf16_t, X_CKV); g.Bt = (pg8::bf16_t*)(wl + (uq ? W_UQT : W_UKVT)); g.M = M; g.N = 512; g.K = uq ? 384 : 256;
            pg8::StaticOrder S; S.init(M, 512, half, uq ? c : c - half);
            epi::EpiMla E{uq ? 0 : 1, F.ws};
            pg8::gemm_phase<epi::EpiMla, pg8::StaticOrder, true, true>(ring, g, S, E, F.wave);
            const bool gm1 = MK_SINGLE && __builtin_amdgcn_readfirstlane(MISC[10]) != 0u;
            if (gm1) grp_arrive(bar, (unsigned)c & 7u, 0u); else __syncthreads();
            attn_a_phase(F, AV, l);
            if (gm1) grp_arrive(bar, (unsigned)c & 7u, 1u);
        } break;
        case 2: if (PH_ON(2)) { const bool gm2 = MK_SINGLE && __builtin_amdgcn_readfirstlane(MISC[10]) != 0u; attn_phase(F, AV, l, dry, gm2, bar, (unsigned)c & 7u); } break;
        case 3: break;
        case 4: if (PH_ON(4)) {
            pg8::Gemm g{WSP(pg8::bf16_t, X_QO), (pg8::bf16_t*)(wl + W_OT), M, 1024, 1024}; pg8::StaticOrder S; S.init(M, 1024, G, c);
            epi::EpiRes E{WSP(pg8::bf16_t, WS_HBA), WSP(pg8::bf16_t, WS_HBB), WSP(float, WS_SSQB), dry};
            pg8::gemm_phase<epi::EpiRes, pg8::StaticOrder, true, true>(ring, g, S, E, F.wave);
        } break;
        case 5: if (PH_ON(5)) {
            { const int rem_ = ((M / 256) * (NUP / 256)) % G;
              if (c >= rem_) { if (l + 1 < DEPTH) convert_next_layer(F, AV, l + 1, c - rem_, G - rem_);
                  else {
                      pg8::Gemm g2{WSP(pg8::bf16_t, WS_PB), (pg8::bf16_t*)(wl + W_PPT), M, 1024, 256}; pg8::StaticOrder S2; S2.init(M, 1024, G - rem_, c - rem_);
                      epi::EpiSpill E2{WSP(pg8::bf16_t, X_ESC)};
                      pg8::gemm_phase<epi::EpiSpill, pg8::StaticOrder, true, true>(ring, g2, S2, E2, F.wave); } } }
            pg8::Gemm g{WSP(pg8::bf16_t, WS_HBB), (pg8::bf16_t*)(wl + W_UPT), M, NUP, 1024}; pg8::StaticOrder S; S.init(M, NUP, G, c);
            epi::EpiUpConv E{WSP(float, WS_SSQB), WSP(pg8::bf16_t, WS_ACT), WSP(float, WS_HALO), AV.in(I_CONV_W) + (size_t)l * 3 * NUP, AV.in(I_CONV_B) + (size_t)l * NUP, (PG8_LAS float*)(F.lds + XL_OFF), (PG8_LAS float*)(F.lds + CWL_OFF), (PG8_LAS float*)(F.lds + RSL_OFF)};
            pg8::gemm_phase<epi::EpiUpConv, pg8::StaticOrder, true, true>(ring, g, S, E, F.wave);
        } break;
        case 6: if (PH_ON(5)) fixup_phase(F, AV, l); break;
        case 7: if (PH_ON(7)) {
            pg8::Gemm g{WSP(pg8::bf16_t, WS_ACT), (pg8::bf16_t*)(wl + W_DNT), M, 1024, DFF}; pg8::StaticOrder S; S.init(M, 1024, G, c);
            epi::EpiRes E{WSP(pg8::bf16_t, WS_HBB), WSP(pg8::bf16_t, WS_HBB), WSP(float, WS_SSQC), dry};
            pg8::gemm_phase<epi::EpiRes, pg8::StaticOrder, true, true>(ring, g, S, E, F.wave);
        } break;
        default: if (PH_ON(8)) {
            pg8::bf16_t* esc = WSP(pg8::bf16_t, X_ESC) + (size_t)F.vcu * 65536;
            if (l + 1 < DEPTH) { pg8::Gemm g{WSP(pg8::bf16_t, WS_PB), (pg8::bf16_t*)(wl + W_PPT), M, 1024, 256}; pg8::StaticOrder S; S.init(M, 1024, G, c);
              epi::EpiSpill E{WSP(pg8::bf16_t, X_ESC)};
              pg8::gemm_phase<epi::EpiSpill, pg8::StaticOrder, true, true>(ring, g, S, E, F.wave); }
            { pg8::Gemm g{WSP(pg8::bf16_t, WS_HBB), (pg8::bf16_t*)(wl + W_GT), M, 1024, 1024}; pg8::StaticOrder S; S.init(M, 1024, G, c);
              epi::EpiPle E{WSP(float, WS_SSQC), esc, WSP(pg8::bf16_t, WS_HBB), WSP(pg8::bf16_t, WS_HBA), WSP(float, WS_SSQA), dry};
              pg8::gemm_phase<epi::EpiPle, pg8::StaticOrder, true, true>(ring, g, S, E, F.wave); }
        } break;
        }
        if (ph + 1 < ph_hi && (k != 3 || is_final) && !(MK_SINGLE && k == 1 && !is_final && __builtin_amdgcn_readfirstlane(MISC[10]) != 0u)) {
#if defined(PROBE_DUP) || !MK_SINGLE
            xcd_barrier(bar);
#else
            unsigned gm_ = MISC[10]; gm_ = __builtin_amdgcn_readfirstlane(gm_);
            if (gm_ != 0u && k >= 0 && !is_final) grp_barrier(bar, (unsigned)c & 7u, 32u  , (unsigned)ph + 1u,
                                                              (k == 4) ? (unsigned)(1 + PH_PER_LAYER * l + 2) + 1u : (k >= 8) ? (unsigned)(1 + PH_PER_LAYER * l + 7) + 1u : 0u, false);
            else xcd_barrier(bar);
            if (ph == 0) { if (F.wave == 0) { const unsigned m_ = grp_mode(bar.bar, G); if (pg8::lane_now() == 0) MISC[10] = m_; } __syncthreads(); }
#endif
        }
    }
}

extern "C" void kernel_launch(void* const* d_in, const int* in_sizes, int n_in, void* d_out, int out_size, void* d_ws, size_t ws_size, hipStream_t stream) {
    static int grid = 0;
    if (grid == 0) {
        if (n_in != 24 || out_size != M * DMODEL || ws_size < WS_END) { fprintf(stderr, "kernel_launch: unexpected problem (n_in %d, out %d, ws %zu; need ws >= %zu)\n", n_in, out_size, ws_size, (size_t)WS_END); grid = -1; return; }
        int dev = 0, cus = 0, per_cu = 0;
        if (hipGetDevice(&dev) != hipSuccess || hipDeviceGetAttribute(&cus, hipDeviceAttributeMultiprocessorCount, dev) != hipSuccess) { grid = -1; return; }
        if (hipFuncSetAttribute((const void*)fwd_kernel, hipFuncAttributeMaxDynamicSharedMemorySize, LDS_BYTES) != hipSuccess) { fprintf(stderr, "kernel_launch: hipFuncSetAttribute failed\n"); grid = -1; return; }
        if (hipOccupancyMaxActiveBlocksPerMultiprocessor(&per_cu, (const void*)fwd_kernel, NTHREADS, LDS_BYTES) != hipSuccess || per_cu < 1) { fprintf(stderr, "kernel_launch: occupancy query says %d blocks per CU\n", per_cu); (void)hipGetLastError(); grid = -1; return; }
        grid = cus;
    }
    if (grid < 0) return;
    if (hipMemsetAsync((char*)d_ws + WS_CTL, 0, CTL_ZERO_BYTES, stream) != hipSuccess) return;
    Args a{};
    for (int i = 0; i < 24; ++i) a.in[i] = (const float*)d_in[i];
    a.out = (float*)d_out; a.ws = (unsigned char*)d_ws;
#if MK_SINGLE
    a.ph_lo = 0; a.ph_hi = N_PHASES;
#ifdef PROBE_DUP
    a.ph_hi = DEPTH * (PH_PER_LAYER + 1) + 2;
#endif
    hipLaunchKernelGGL(fwd_kernel, dim3(grid), dim3(NTHREADS), LDS_BYTES, stream, a);
#else
    for (int ph = 0; ph < N_PHASES; ++ph) {
        a.ph_lo = ph; a.ph_hi = ph + 1;
        hipLaunchKernelGGL(fwd_kernel, dim3(grid), dim3(NTHREADS), LDS_BYTES, stream, a);
    }
#endif
}
```

```cpp
#include <hip/hip_runtime.h>
#include <cstdio>
#include <cstdint>
#include <cmath>
#define MK_SINGLE 1
namespace pg8 {
__device__ __forceinline__ int lane_now() { int l; asm volatile("v_mbcnt_lo_u32_b32 %0, -1, 0\n\tv_mbcnt_hi_u32_b32 %0, -1, %0" : "=v"(l)); return l; }
#define PG8_LAS __attribute__((address_space(3)))
typedef unsigned short bf16_t;
typedef short bf16x8 __attribute__((ext_vector_type(8)));
typedef float f32x4 __attribute__((ext_vector_type(4)));
typedef unsigned u32x4 __attribute__((ext_vector_type(4)));
constexpr int BM = 256, BK = 64, HALF = 128, HTB = HALF * BK * 2  , STAGE_BYTES = 8 * HTB, NXCD = 8, WGM = 8;

__host__ __device__ __forceinline__ int lds_byte(int r, int c) { const int st = (r >> 4) * 2 + (c >> 5), rr = r & 15, cc = c & 31, ob = rr * 64 + cc * 2; return st * 1024 + (ob ^ (((ob >> 9) & 1) << 5)); }
__host__ __device__ __forceinline__ void stage_rc(int b, int& R, int& C) { const int st = b / 1024, sb = b % 1024, swz = sb ^ (((sb >> 9) & 1) << 5); R = (st >> 1) * 16 + swz / 64; C = (st & 1) * 32 + (swz % 64) / 2; }
__host__ __device__ __forceinline__ int perm32(int rho) { const int n = rho >> 4, i = rho & 15; return 8 * (i >> 2) + 4 * n + (i & 3); }

struct Unit { int pm, pn; };
struct Gemm { const bf16_t* A; const bf16_t* Bt; int M, N, K; };

struct StaticOrder {
    int nM, nN, nwg, G, c;
    __host__ __device__ void init(int M, int N, int G_, int c_) { nM = M / BM; nN = N / BM; nwg = nM * nN; G = G_; c = c_; }
    __host__ __device__ bool next(int i, Unit& u) const {
        const long L = (long)i * G + c; if (L >= nwg) return false;
        int wgid = (int)L; { const int q = nwg / NXCD, r = nwg % NXCD, xcd = wgid % NXCD, off = wgid / NXCD; wgid = (xcd < r ? xcd * (q + 1) : r * (q + 1) + (xcd - r) * q) + off; }
        const int nig = WGM * nN, gid = wgid / nig, fm = gid * WGM, gsz = (nM - fm) < WGM ? (nM - fm) : WGM;
        u.pm = fm + ((wgid % nig) % gsz); u.pn = (wgid % nig) / gsz; return true;
    }
    __device__ __forceinline__ void a_ready(const Unit&) const {}
    __device__ __forceinline__ void done(const Unit&) const {}
};
__device__ __forceinline__ unsigned cvt_pk_bf16(float lo, float hi) { unsigned r; asm volatile("v_cvt_pk_bf16_f32 %0, %1, %2" : "=v"(r) : "v"(lo), "v"(hi)); return r; }
typedef float f32x2 __attribute__((ext_vector_type(2)));
template <class Epi, class Sched, bool ALIGN_EPI = false, bool SP2 = false>
__device__ __forceinline__ void gemm_phase(PG8_LAS unsigned char* lds, const Gemm g, const Sched& S, const Epi& E, int wave_id) {
    int tid_ = (wave_id << 6) | lane_now();
    const int tid = tid_, wid = __builtin_amdgcn_readfirstlane(tid >> 6), lane = tid & 63, wr = wid >> 2, wc = wid & 3, fr = lane & 15, fq = lane >> 4;
    int K_ = __builtin_amdgcn_readfirstlane(g.K); asm volatile("" : "+s"(K_));
    const int K = K_, nt = K / BK;
    unsigned voffA[2], voffB[2];
#pragma unroll
    for (int i = 0; i < 2; ++i) { int R, C; stage_rc(tid * 16 + i * 8192, R, C); const int Rb = Epi::PERM ? ((R & ~31) + perm32(R & 31)) : R;
        const int Ra = Epi::AROWPERM ? ((R & ~63) + (((R & 15) << 2) | ((R >> 4) & 3))) : R;
        voffA[i] = (unsigned)(Ra * K + C) * 2u; voffB[i] = (unsigned)(Rb * K + C) * 2u; }
    const size_t kstep = (size_t)(BK * 2);
    const size_t hstep = (size_t)HALF * K * 2;
    const size_t tstep = 2 * hstep;
    const unsigned ldsw = (unsigned)wid * 1024u;
    const int aoff = lds_byte(wr * 64 + fr, fq * 8), boff = lds_byte(wc * 32 + fr, fq * 8);
#define PG8_SA(b, h) (((b) * 2 + (h)) * HTB)
#define PG8_SB(b, h) ((4 + (b) * 2 + (h)) * HTB)
#define PG8_STAGE(bufoff, gbase, voff) do { _Pragma("unroll") for (int _i = 0; _i < 2; ++_i) \
        __builtin_amdgcn_global_load_lds((const unsigned*)((const char*)(gbase) + (voff)[_i]), (PG8_LAS unsigned*)(lds + (bufoff) + ldsw + _i * 8192), 16, 0, 0); } while (0)
#define PG8_LDA(dst, b, h) do { _Pragma("unroll") for (int m = 0; m < 4; ++m) _Pragma("unroll") for (int k = 0; k < 2; ++k) dst[m][k] = *(const PG8_LAS bf16x8*)(lds + PG8_SA(b, h) + aoff + m * 2048 + k * 1024); } while (0)
#define PG8_LDB(dst, b, h) do { _Pragma("unroll") for (int n = 0; n < 2; ++n) _Pragma("unroll") for (int k = 0; k < 2; ++k) dst[n][k] = *(const PG8_LAS bf16x8*)(lds + PG8_SB(b, h) + boff + n * 2048 + k * 1024); } while (0)
#define PG8_MMA(ai, bj, At, Bt) do { __builtin_amdgcn_s_setprio(1); _Pragma("unroll") for (int m = 0; m < 4; ++m) _Pragma("unroll") for (int n = 0; n < 2; ++n) _Pragma("unroll") for (int k = 0; k < 2; ++k) \
        acc[ai][bj][m][n] = __builtin_amdgcn_mfma_f32_16x16x32_bf16(Bt[n][k], At[m][k], acc[ai][bj][m][n], 0, 0, 0); __builtin_amdgcn_s_setprio(0); } while (0)
#define PG8_WAIT_V(n) asm volatile("s_waitcnt vmcnt(" #n ")" ::: "memory")
#define PG8_WAIT_L(n) asm volatile("s_waitcnt lgkmcnt(" #n ")" ::: "memory")
#define PG8_BAR __builtin_amdgcn_s_barrier()
#define PG8_SCHED __builtin_amdgcn_sched_barrier(0)
    Unit cur, nxt; int ui = 0;
    if (!S.next(0, cur)) return;
    typename Epi::Carry cy; if constexpr (Epi::STAGED) { cy.pm = -1; E.stage(cur, 0, wid, lane); }
    f32x4 acc[2][2][4][2];
#pragma unroll
    for (int a = 0; a < 2; ++a)
#pragma unroll
        for (int b = 0; b < 2; ++b)
#pragma unroll
            for (int m = 0; m < 4; ++m)
#pragma unroll
                for (int n = 0; n < 2; ++n) acc[a][b][m][n] = (f32x4){0.f, 0.f, 0.f, 0.f};
    bf16x8 At[4][2], B0[2][2], B1[2][2];
    const char* cA = (const char*)g.A + (size_t)cur.pm * tstep; const char* cB = (const char*)g.Bt + (size_t)cur.pn * tstep;
    S.a_ready(cur);
    if constexpr (SP2) {
        PG8_STAGE(PG8_SB(0, 0), cB, voffB); PG8_STAGE(PG8_SB(0, 1), cB + hstep, voffB); PG8_STAGE(PG8_SA(0, 0), cA, voffA); PG8_STAGE(PG8_SA(0, 1), cA + hstep, voffA);
        if (wr == 1) PG8_BAR;
        PG8_WAIT_V(2); PG8_BAR;
        PG8_STAGE(PG8_SB(1, 0), cB + kstep, voffB); PG8_STAGE(PG8_SA(1, 0), cA + kstep, voffA); PG8_STAGE(PG8_SB(1, 1), cB + hstep + kstep, voffB);
        PG8_WAIT_V(6); PG8_BAR;
    } else {
        PG8_STAGE(PG8_SB(0, 0), cB, voffB); PG8_STAGE(PG8_SA(0, 0), cA, voffA); PG8_STAGE(PG8_SB(0, 1), cB + hstep, voffB); PG8_STAGE(PG8_SA(0, 1), cA + hstep, voffA);
        if (wr == 1) PG8_BAR;
        PG8_WAIT_V(4); PG8_BAR;
        PG8_STAGE(PG8_SB(1, 0), cB + kstep, voffB); PG8_STAGE(PG8_SA(1, 0), cA + kstep, voffA); PG8_STAGE(PG8_SB(1, 1), cB + hstep + kstep, voffB);
        PG8_WAIT_V(6); PG8_BAR;
    }
    for (;;) {
        const bool has_next = S.next(ui + 1, nxt);
        const char* nA = has_next ? (const char*)g.A + (size_t)nxt.pm * tstep : cA; const char* nB = has_next ? (const char*)g.Bt + (size_t)nxt.pn * tstep : cB;
        for (int t = 0; t < nt; t += 2) {
            const bool last = (t == nt - 2);
            const char* a1 = cA + (size_t)(t + 1) * kstep;
            const char* a2 = last ? nA : cA + (size_t)(t + 2) * kstep; const char* b2 = last ? nB : cB + (size_t)(t + 2) * kstep;
            const char* a3 = a2 + kstep; const char* b3 = b2 + kstep;
            if (last && has_next) S.a_ready(nxt);
            if constexpr (SP2) {
            const bool tail = last && !has_next;
            PG8_LDB(B0, 0, 0); PG8_LDB(B1, 0, 1); PG8_SCHED; PG8_LDA(At, 0, 0); PG8_STAGE(PG8_SA(1, 1), a1 + hstep, voffA);
            PG8_WAIT_V(8); PG8_WAIT_L(0); PG8_BAR; PG8_MMA(0, 0, At, B0); PG8_MMA(0, 1, At, B1); PG8_BAR; PG8_SCHED;
            PG8_LDA(At, 0, 1);
            if (!tail) { PG8_STAGE(PG8_SB(0, 0), b2, voffB); PG8_STAGE(PG8_SB(0, 1), b2 + hstep, voffB); PG8_STAGE(PG8_SA(0, 0), a2, voffA); PG8_WAIT_V(8); } else { PG8_WAIT_V(2); }
            PG8_WAIT_L(0); PG8_BAR; PG8_MMA(1, 0, At, B0); PG8_MMA(1, 1, At, B1); PG8_BAR; PG8_SCHED;
            PG8_LDB(B0, 1, 0); PG8_LDB(B1, 1, 1); PG8_SCHED; PG8_LDA(At, 1, 0);
            if (!tail) { PG8_STAGE(PG8_SA(0, 1), a2 + hstep, voffA); PG8_WAIT_V(8); } else { PG8_WAIT_V(0); }
            PG8_WAIT_L(0); PG8_BAR; PG8_MMA(0, 0, At, B0); PG8_MMA(0, 1, At, B1); PG8_BAR; PG8_SCHED;
            PG8_LDA(At, 1, 1);
            if (!tail) { PG8_STAGE(PG8_SB(1, 0), b3, voffB); PG8_STAGE(PG8_SB(1, 1), b3 + hstep, voffB); PG8_STAGE(PG8_SA(1, 0), a3, voffA); PG8_WAIT_V(8); }
            PG8_WAIT_L(0); PG8_BAR; PG8_MMA(1, 0, At, B0); PG8_MMA(1, 1, At, B1); PG8_BAR; PG8_SCHED;
            } else {
            PG8_LDB(B0, 0, 0); PG8_SCHED; PG8_LDA(At, 0, 0); PG8_STAGE(PG8_SA(1, 1), a1 + hstep, voffA);
            PG8_WAIT_L(8); PG8_BAR; PG8_WAIT_L(0); PG8_MMA(0, 0, At, B0); PG8_BAR; PG8_SCHED;
            PG8_LDB(B1, 0, 1); PG8_STAGE(PG8_SB(0, 0), b2, voffB);
            PG8_BAR; PG8_WAIT_L(0); PG8_MMA(0, 1, At, B1); PG8_BAR;
            PG8_LDA(At, 0, 1); PG8_STAGE(PG8_SA(0, 0), a2, voffA);
            PG8_BAR; PG8_WAIT_L(0); PG8_MMA(1, 0, At, B0); PG8_BAR; PG8_SCHED;
            PG8_STAGE(PG8_SB(0, 1), b2 + hstep, voffB);
            PG8_WAIT_V(6); PG8_BAR; PG8_MMA(1, 1, At, B1); PG8_BAR;
            PG8_LDB(B0, 1, 0); PG8_SCHED; PG8_LDA(At, 1, 0); PG8_STAGE(PG8_SA(0, 1), a2 + hstep, voffA);
            PG8_WAIT_L(8); PG8_BAR; PG8_WAIT_L(0); PG8_MMA(0, 0, At, B0); PG8_BAR; PG8_SCHED;
            PG8_LDB(B1, 1, 1); PG8_STAGE(PG8_SB(1, 0), b3, voffB);
            PG8_BAR; PG8_WAIT_L(0); PG8_MMA(0, 1, At, B1); PG8_BAR;
            PG8_LDA(At, 1, 1); PG8_STAGE(PG8_SA(1, 0), a3, voffA);
            PG8_BAR; PG8_WAIT_L(0); PG8_MMA(1, 0, At, B0); PG8_BAR; PG8_SCHED;
            PG8_STAGE(PG8_SB(1, 1), b3 + hstep, voffB);
            PG8_WAIT_V(6); PG8_BAR; PG8_MMA(1, 1, At, B1); PG8_BAR;
            }
        }
        if constexpr (ALIGN_EPI) { if (wr == 0) PG8_BAR; }
        if constexpr (!Epi::AFTER_DRAIN) { if constexpr (Epi::STAGED) E(acc, cur, wr, wc, fr, fq, cy, ui & 1); else E(acc, cur, wr, wc, fr, fq); S.done(cur); }
        if (!has_next) break;
#pragma unroll
        for (int a = 0; a < 2; ++a)
#pragma unroll
            for (int b = 0; b < 2; ++b)
#pragma unroll
                for (int m = 0; m < 4; ++m)
#pragma unroll
                    for (int n = 0; n < 2; ++n) acc[a][b][m][n] = (f32x4){0.f, 0.f, 0.f, 0.f};
        cur = nxt; cA = nA; cB = nB; ++ui;
        if constexpr (Epi::STAGED) E.stage(cur, ui & 1, wid, lane_now());
        if constexpr (ALIGN_EPI) { if (wr == 1) PG8_BAR; }
    }
    PG8_WAIT_V(0);
    if constexpr (!ALIGN_EPI) { if (wr == 0) PG8_BAR; }
    PG8_BAR;
    if constexpr (Epi::AFTER_DRAIN) { E.fused(acc, cur, wr, wc, fr, fq, lds, wid, lane); S.done(cur); }
#undef PG8_SA
#undef PG8_SB
#undef PG8_STAGE
#undef PG8_LDA
#undef PG8_LDB
#undef PG8_MMA
#undef PG8_WAIT_V
#undef PG8_WAIT_L
#undef PG8_BAR
#undef PG8_SCHED
}
}
#define GAS __attribute__((address_space(1)))
#define LAS __attribute__((address_space(3)))
typedef unsigned short bf16;
typedef unsigned v4u __attribute__((ext_vector_type(4)));
typedef float f32x4 __attribute__((ext_vector_type(4)));
typedef short bf16x8 __attribute__((ext_vector_type(8)));
typedef GAS unsigned gu32;
typedef GAS unsigned long long gu64;
#define RLX_AGENT __ATOMIC_RELAXED, __HIP_MEMORY_SCOPE_AGENT
#define LDS_WAIT() asm volatile("s_waitcnt lgkmcnt(0)" ::: "memory")
#define VM_WAIT() asm volatile("s_waitcnt vmcnt(0)" ::: "memory")
__device__ __forceinline__ unsigned long long rt() { return __builtin_amdgcn_s_memrealtime(); }
__device__ __forceinline__ unsigned f2bf(float f) { unsigned u = __builtin_bit_cast(unsigned, f); return (u + 0x7fffu + ((u >> 16) & 1u)) >> 16; }
__device__ __forceinline__ unsigned pk2(float lo, float hi) { return f2bf(lo) | (f2bf(hi) << 16); }

#define XB_TMO      128
#define XB_XCNT(j)  (256  + 64 * (j))
#define XB_XSUB(j)  (1280 + 64 * (j))
#define XB_XGEN(j)  (2304 + 64 * (j))
#define XB_TOP      3328
#define XB_TOPGEN   3392
#define XCD_BAR_WORDS 3456
#define XB_SPIN_CAP (1u << 18)
#define XB_CW_BAR 4096
#define XB_CW_GRP 8192
#define XB_CW_XCC 12288

__device__ __forceinline__ unsigned xb_ld(unsigned* p)              { return __hip_atomic_load(p, __ATOMIC_RELAXED, __HIP_MEMORY_SCOPE_AGENT); }
__device__ __forceinline__ unsigned xb_add(unsigned* p, unsigned v) { return __hip_atomic_fetch_add(p, v, __ATOMIC_RELAXED, __HIP_MEMORY_SCOPE_AGENT); }
__device__ __forceinline__ unsigned xb_xcc_id() { return (unsigned)__builtin_amdgcn_s_getreg((3 << 11) | 20) & 0xFu; }
#define XB_SPIN(cond, bar) do { unsigned _sp = 0; while (cond) { __builtin_amdgcn_s_sleep(1); \
    if ((++_sp & 255u) == 0u) { if (xb_ld(&(bar)[XB_TMO])) break; if (_sp > XB_SPIN_CAP) { atomicAdd(&(bar)[XB_TMO], 1u); break; } } } } while (0)

struct XcdBarrier {
    int wave;
    unsigned* bar; unsigned x;
    volatile LAS unsigned* st;
};

__device__ __forceinline__ XcdBarrier xcd_barrier_post(unsigned* bar, volatile LAS unsigned* st, int wave) {
    XcdBarrier b; b.wave = wave; b.bar = bar; b.x = xb_xcc_id(); b.st = st;
    if (wave == 0 && pg8::lane_now() == 0) { __hip_atomic_store(bar + (XB_CW_XCC - XB_CW_BAR) + blockIdx.x, b.x + 1u, __ATOMIC_RELAXED, __HIP_MEMORY_SCOPE_AGENT); (void)xb_add(&bar[XB_XCNT(b.x)], 1u); }
    return b;
}
__device__ __forceinline__ void xcd_barrier_complete(unsigned* bar, unsigned x, unsigned& nloc, unsigned& nx) {
    const unsigned G = gridDim.x * gridDim.y * gridDim.z;
    unsigned sum, cnt, mine, sp = 0u;
    for (;;) {
        sum = 0u; cnt = 0u; mine = 0u;
        unsigned cv[16];
        { unsigned* cb = bar + XB_XCNT(0);
          asm volatile("global_load_dword %0, %16, off sc1\n\tglobal_load_dword %1, %16, off offset:256 sc1\n\tglobal_load_dword %2, %16, off offset:512 sc1\n\tglobal_load_dword %3, %16, off offset:768 sc1\n\t"
                       "global_load_dword %4, %16, off offset:1024 sc1\n\tglobal_load_dword %5, %16, off offset:1280 sc1\n\tglobal_load_dword %6, %16, off offset:1536 sc1\n\tglobal_load_dword %7, %16, off offset:1792 sc1\n\t"
                       "global_load_dword %8, %16, off offset:2048 sc1\n\tglobal_load_dword %9, %16, off offset:2304 sc1\n\tglobal_load_dword %10, %16, off offset:2560 sc1\n\tglobal_load_dword %11, %16, off offset:2816 sc1\n\t"
                       "global_load_dword %12, %16, off offset:3072 sc1\n\tglobal_load_dword %13, %16, off offset:3328 sc1\n\tglobal_load_dword %14, %16, off offset:3584 sc1\n\tglobal_load_dword %15, %16, off offset:3840 sc1\n\t"
                       "s_waitcnt vmcnt(0)"
                       : "=&v"(cv[0]), "=&v"(cv[1]), "=&v"(cv[2]), "=&v"(cv[3]), "=&v"(cv[4]), "=&v"(cv[5]), "=&v"(cv[6]), "=&v"(cv[7]),
                         "=&v"(cv[8]), "=&v"(cv[9]), "=&v"(cv[10]), "=&v"(cv[11]), "=&v"(cv[12]), "=&v"(cv[13]), "=&v"(cv[14]), "=&v"(cv[15]) : "v"(cb) : "memory"); }
#pragma unroll
        for (unsigned j = 0; j < 16; ++j) { const unsigned c = cv[j]; sum += c; cnt += (c > 0u) ? 1u : 0u; mine = (j == x) ? c : mine; }
        if (sum == G) break;
        __builtin_amdgcn_s_sleep(1);
        if ((++sp & 255u) == 0u) { if (xb_ld(&bar[XB_TMO])) break; if (sp > XB_SPIN_CAP) { atomicAdd(&bar[XB_TMO], 1u); break; } }
    }
    nloc = mine > 0u ? mine : 1u; nx = cnt > 0u ? cnt : 1u;
}

__device__ __forceinline__ void xcd_barrier(const XcdBarrier& b) {
    asm volatile("s_waitcnt vmcnt(0)" ::: "memory");
    __syncthreads();
    if (b.wave == 0 && pg8::lane_now() == 0) {
        unsigned* bar = b.bar; asm volatile("" : "+s"(bar));
        __builtin_amdgcn_s_waitcnt(0);
        unsigned nloc = b.st[0], nx = b.st[1];
        if (nloc == 0u) { xcd_barrier_complete(bar, b.x, nloc, nx); b.st[0] = nloc; b.st[1] = nx; }
        const unsigned old = xb_add(&bar[XB_XSUB(b.x)], 1u);
        const unsigned gen = old / nloc;
        if (old + 1u == (gen + 1u) * nloc) {
            __builtin_amdgcn_fence(__ATOMIC_RELEASE, "agent");
            asm volatile("s_waitcnt vmcnt(0)" ::: "memory");
            const unsigned og = xb_add(&bar[XB_TOP], 1u);
            const unsigned tg = og / nx;
            if (og + 1u == (tg + 1u) * nx) xb_add(&bar[XB_TOPGEN], 1u);
            else XB_SPIN(xb_ld(&bar[XB_TOPGEN]) == tg, bar);
            __builtin_amdgcn_fence(__ATOMIC_ACQUIRE, "agent");
            xb_add(&bar[XB_XGEN(b.x)], 1u);
            asm volatile("s_waitcnt vmcnt(0)" ::: "memory");
        } else {
            XB_SPIN(xb_ld(&bar[XB_XGEN(b.x)]) == gen, bar);
            __builtin_amdgcn_fence(__ATOMIC_ACQUIRE, "agent");
            asm volatile("s_waitcnt vmcnt(0)" ::: "memory");
        }
    }
    __syncthreads();
}

__device__ __forceinline__ void grp_barrier(const XcdBarrier& b, unsigned x, unsigned nloc, unsigned publish, unsigned need, bool release) {
    asm volatile("s_waitcnt vmcnt(0)" ::: "memory");
    __syncthreads();
    if (b.wave == 0 && pg8::lane_now() == 0) {
        unsigned* bar = b.bar; asm volatile("" : "+s"(bar));
        __builtin_amdgcn_s_waitcnt(0);
        asm volatile("buffer_inv sc1" ::: "memory");
        unsigned* sub = bar + (XB_CW_GRP - XB_CW_BAR) + 64u * x; unsigned* genw = sub + 1024; unsigned* prog = bar + (XB_CW_GRP - XB_CW_BAR) + 2048;
        const unsigned old = xb_add(sub, 1u);
        const unsigned gen = old / nloc;
        if (old + 1u == (gen + 1u) * nloc) {
            if (release) { __builtin_amdgcn_fence(__ATOMIC_RELEASE, "agent"); asm volatile("s_waitcnt vmcnt(0)" ::: "memory"); }
            __hip_atomic_store(prog + 64u * x, publish, __ATOMIC_RELAXED, __HIP_MEMORY_SCOPE_AGENT);
            if (need != 0u) {
                unsigned sp_ = 0u;
                for (;;) {
                    unsigned pv[8];
                    asm volatile("global_load_dword %0, %8, off sc1\n\tglobal_load_dword %1, %8, off offset:256 sc1\n\tglobal_load_dword %2, %8, off offset:512 sc1\n\tglobal_load_dword %3, %8, off offset:768 sc1\n\t"
                                 "global_load_dword %4, %8, off offset:1024 sc1\n\tglobal_load_dword %5, %8, off offset:1280 sc1\n\tglobal_load_dword %6, %8, off offset:1536 sc1\n\tglobal_load_dword %7, %8, off offset:1792 sc1\n\t"
                                 "s_waitcnt vmcnt(0)"
                                 : "=&v"(pv[0]), "=&v"(pv[1]), "=&v"(pv[2]), "=&v"(pv[3]), "=&v"(pv[4]), "=&v"(pv[5]), "=&v"(pv[6]), "=&v"(pv[7]) : "v"(prog) : "memory");
                    unsigned mn = pv[0];
#pragma unroll
                    for (unsigned g = 1; g < 8u; ++g) mn = pv[g] < mn ? pv[g] : mn;
                    if (mn >= need) break;
                    __builtin_amdgcn_s_sleep(1);
                    if ((++sp_ & 255u) == 0u) { if (xb_ld(&bar[XB_TMO])) break; if (sp_ > XB_SPIN_CAP) { atomicAdd(&bar[XB_TMO], 1u); break; } }
                }
            }
            xb_add(genw, 1u);
        } else XB_SPIN(xb_ld(genw) == gen, bar);
        asm volatile("s_waitcnt vmcnt(0)" ::: "memory");
    }
    __syncthreads();
}
__device__ __forceinline__ void grp_arrive(const XcdBarrier& b, unsigned x, unsigned slot) {
    asm volatile("s_waitcnt vmcnt(0)" ::: "memory");
    __syncthreads();
    if (b.wave == 0 && pg8::lane_now() == 0) {
        unsigned* bar = b.bar; asm volatile("" : "+s"(bar));
        __builtin_amdgcn_s_waitcnt(0);
        (void)xb_add(bar + (XB_CW_GRP - XB_CW_BAR) + 3072u + 512u * slot + 64u * x, 1u);
    }
}
__device__ __forceinline__ void grp_wait(const XcdBarrier& b, unsigned x, unsigned slot, unsigned target) {
    if (b.wave == 0 && pg8::lane_now() == 0) {
        unsigned* bar = b.bar; asm volatile("" : "+s"(bar));
        unsigned* w = bar + (XB_CW_GRP - XB_CW_BAR) + 3072u + 512u * slot + 64u * x;
        XB_SPIN(xb_ld(w) < target, bar);
        asm volatile("buffer_inv sc1\n\ts_waitcnt vmcnt(0)" ::: "memory");
    }
    __syncthreads();
}
__device__ __forceinline__ unsigned grp_mode(unsigned* bar, int G) {
    const int ln = pg8::lane_now();
    bool ok = (G == 256);
    if (ok) {
        const unsigned* xa = bar + (XB_CW_XCC - XB_CW_BAR) + 4 * ln; const unsigned* xr = bar + (XB_CW_XCC - XB_CW_BAR) + 4 * (ln & 1);
        v4u a, r;
        asm volatile("global_load_dwordx4 %0, %2, off sc1\n\tglobal_load_dwordx4 %1, %3, off sc1\n\ts_waitcnt vmcnt(0)" : "=&v"(a), "=&v"(r) : "v"(xa), "v"(xr) : "memory");
        ok = (a.x == r.x) && (a.y == r.y) && (a.z == r.z) && (a.w == r.w) && (a.x != 0u) && (a.y != 0u) && (a.z != 0u) && (a.w != 0u);
    }
    return (__ballot(ok) == ~0ull) ? 1u : 0u;
}

constexpr int DMODEL = 1024, NBATCH = 8, SEQ = 2048, DEPTH = 4, M = NBATCH * SEQ;
constexpr int IN_COLS = 2976, N1 = 3072, DFF = 2816, NUP = 2 * DFF, PLE = 256;
constexpr int OFF_A = 0, OFF_B = 768, OFF_C = 1440, OFF_D = 2208;
constexpr float LOG2E = 1.4426950408889634f;
constexpr float SC_A = 0.125f * LOG2E, SC_C = 0.17677669529663687f * LOG2E, SC_D = 0.125f * LOG2E, SC_B = 0.10206207261596575f * LOG2E;
constexpr float NORM_EPS = 1e-6f;
constexpr int NWAVES = 8, NTHREADS = 512;
constexpr int PH_PER_LAYER = 9, N_PHASES = DEPTH * PH_PER_LAYER + 2;

#ifndef MK_SINGLE
#define MK_SINGLE 1
#endif

constexpr size_t KiB = 1024, MiB = 1u << 20;
constexpr size_t WS_CTL = 0, CTL_ZERO_BYTES = 1 * MiB;
constexpr size_t WS_TAB64 = 1 * MiB, WS_TAB32 = WS_TAB64 + 512 * KiB;
constexpr size_t WS_SSQA = 2 * MiB, WS_SSQB = 3 * MiB, WS_SSQC = 4 * MiB, WS_SSQCQ = 5 * MiB, WS_SSQCKV = 5 * MiB + 512 * KiB;
constexpr size_t WS_HALO = 6 * MiB;
constexpr size_t WS_W = 12 * MiB, W_STRIDE = 28 * MiB;
constexpr size_t W_1T = 0, W_UPT = 6 * MiB, W_DNT = 17 * MiB, W_OT = 22 * MiB + 512 * KiB, W_GT = 24 * MiB + 512 * KiB, W_PPT = 26 * MiB + 512 * KiB, W_UQT = 27 * MiB, W_UKVT = 27 * MiB + 384 * KiB;
constexpr size_t WS_HBA = 124 * MiB, WS_HBB = 156 * MiB, WS_PB = 188 * MiB, WS_X = 196 * MiB, WS_END = 328 * MiB;
constexpr size_t X_QO = WS_X, X_KA = WS_X + 32 * MiB, X_VA = WS_X + 40 * MiB, X_KC = WS_X + 48 * MiB, X_VC = WS_X + 56 * MiB, X_KD = WS_X + 64 * MiB, X_VD = WS_X + 72 * MiB;
constexpr size_t X_CQ = WS_X + 80 * MiB, X_CKV = WS_X + 92 * MiB, X_QB = WS_X + 100 * MiB, X_KB = WS_X + 112 * MiB, X_VB = WS_X + 124 * MiB;
constexpr size_t WS_ACT = WS_X + 32 * MiB, X_ESC = X_QO;
static_assert(W_UKVT + 512 * 256 * 2 <= W_STRIDE && WS_W + DEPTH * W_STRIDE <= WS_HBA && X_VB + (size_t)M * 256 * 2 <= WS_END && WS_ACT + (size_t)M * DFF * 2 <= WS_END && WS_HALO + (size_t)64 * 4 * NUP * 4 <= WS_W, "d_ws map");
constexpr int CW_BAR = 4096;
constexpr int CW_GRP = 8192, CW_XCC = 12288;

constexpr int RING_BYTES = 131072, LDSCTL_OFF = RING_BYTES, MISC_OFF = LDSCTL_OFF + 320, XL_OFF = RING_BYTES + 512, CWL_OFF = 147456, RSL_OFF = 155648, LDS_BYTES = 159744;

typedef float f32x2v __attribute__((ext_vector_type(2)));
typedef float f32x16 __attribute__((ext_vector_type(16)));
typedef unsigned u32x2v __attribute__((ext_vector_type(2)));
using pg8::cvt_pk_bf16;

__device__ __forceinline__ float bf2f(unsigned short x) { return __uint_as_float((unsigned)x << 16); }
__device__ __forceinline__ float bflo(unsigned w) { return __uint_as_float(w << 16); }
__device__ __forceinline__ float bfhi(unsigned w) { return __uint_as_float(w & 0xffff0000u); }
template <int X> __device__ __forceinline__ float swz_xor(float v) { return __int_as_float(__builtin_amdgcn_ds_swizzle(__float_as_int(v), (X << 10) | 0x1f)); }
__device__ __forceinline__ float wave_sum(float v) {
    v += swz_xor<1>(v); v += swz_xor<2>(v); v += swz_xor<4>(v); v += swz_xor<8>(v); v += swz_xor<16>(v);
    auto b = __builtin_amdgcn_permlane32_swap(__float_as_uint(v), __float_as_uint(v), false, false); return __uint_as_float(b[0]) + __uint_as_float(b[1]);
}
__device__ __forceinline__ float g16_sum(float v) { v += swz_xor<1>(v); v += swz_xor<2>(v); v += swz_xor<4>(v); v += swz_xor<8>(v); return v; }
__device__ __forceinline__ float fast_rcp(float x) { return __builtin_amdgcn_rcpf(x); }
__device__ __forceinline__ float fast_exp2(float x) { return __builtin_amdgcn_exp2f(x); }

__device__ __forceinline__ void sincos_acc(float ang, float& s, float& c) {
    float K2PI = 0.636619772367581343f, P1 = 1.5703125f, P2 = 4.837512969970703125e-4f, P3 = 7.54978995489188216e-8f;
    float S1 = -1.9515295891e-4f, S2 = 8.3321608736e-3f, S3 = -1.6666654611e-1f, C1 = 2.443315711809948e-5f, C2 = -1.388731625493765e-3f, C3 = 4.166664568298827e-2f;
    asm volatile("" : "+s"(K2PI), "+s"(P1), "+s"(P2), "+s"(P3), "+s"(S1), "+s"(S2), "+s"(S3), "+s"(C1), "+s"(C2), "+s"(C3));
    const float k = rintf(ang * K2PI);
    float r = fmaf(-k, P1, ang);
    r = fmaf(-k, P2, r);
    r = fmaf(-k, P3, r);
    const int q = ((int)k) & 3;
    const float r2 = r * r;
    const float sp = fmaf(r * r2, fmaf(r2, fmaf(r2, S1, S2), S3), r);
    const float cp = fmaf(r2 * r2, fmaf(r2, fmaf(r2, C1, C2), C3), fmaf(r2, -0.5f, 1.0f));
    float sv, cv;
    if (q == 0) { sv = sp; cv = cp; } else if (q == 1) { sv = cp; cv = -sp; } else if (q == 2) { sv = -sp; cv = -cp; } else { sv = -cp; cv = sp; }
    s = sv; c = cv;
}

__device__ const float ROPE_INV[48] = {0x1.0000000000000p+0f, 0x1.7ff2220000000p-1f, 0x1.1feb340000000p-1f, 0x1.afd1360000000p-2f, 0x1.43d1360000000p-2f, 0x1.e5a8480000000p-3f, 0x1.6c310e0000000p-3f, 0x1.111aee0000000p-3f, 0x1.99999a0000000p-4f, 0x1.33281c0000000p-4f, 0x1.ccab860000000p-5f, 0x1.59742a0000000p-5f, 0x1.030dc40000000p-5f, 0x1.8486a00000000p-6f, 0x1.235a720000000p-6f, 0x1.b4f7e20000000p-7f, 0x1.47ae140000000p-7f, 0x1.eb73600000000p-8f, 0x1.7089380000000p-8f, 0x1.145cee0000000p-8f, 0x1.9e7c6e0000000p-9f, 0x1.36d21a0000000p-9f, 0x1.d22a500000000p-10f, 0x1.5d931c0000000p-10f, 0x1.0624de0000000p-10f, 0x1.8929180000000p-11f, 0x1.26d42c0000000p-11f, 0x1.ba2e4c0000000p-12f, 0x1.4b96be0000000p-12f, 0x1.f150280000000p-13f, 0x1.74eea60000000p-13f, 0x1.17a8e40000000p-13f, 0x1.0000000000000p+0f, 0x1.1feb340000000p-1f, 0x1.43d1360000000p-2f, 0x1.6c310e0000000p-3f, 0x1.99999a0000000p-4f, 0x1.ccab860000000p-5f, 0x1.030dc40000000p-5f, 0x1.235a720000000p-6f, 0x1.47ae140000000p-7f, 0x1.7089380000000p-8f, 0x1.9e7c6e0000000p-9f, 0x1.d22a500000000p-10f, 0x1.0624de0000000p-10f, 0x1.26d42c0000000p-11f, 0x1.4b96be0000000p-12f, 0x1.74eea60000000p-13f};

struct Args {
    const float* in[24]; float* out; unsigned char* ws; int ph_lo, ph_hi;
};
struct ArgView {
    const __attribute__((address_space(4))) unsigned char* kp;
    __device__ __forceinline__ const float* in(int i) const { return *(const float* const __attribute__((address_space(4)))*)(kp + 8 * i); }
    __device__ __forceinline__ float* out() const { return *(float* const __attribute__((address_space(4)))*)(kp + 8 * 24); }
};
enum { I_X = 0, I_P, I_ATTN_NORM, I_W_IN, I_QNORM, I_W_UQ, I_KVNORM, I_W_UKV, I_LQ1, I_LK1, I_LQ2, I_LK2, I_SUBLN, I_RPB, I_W_O, I_FFN_NORM, I_W_UP, I_CONV_W, I_CONV_B, I_W_DOWN, I_PLE_NORM, I_W_G, I_W_PP, I_FINAL };

enum { MAP_ID = 0, MAP_IN, MAP_UQ, MAP_UKV, MAP_UP };
__device__ __forceinline__ int map_col(int mt, int n) {
    if (mt == MAP_ID) return n;
    if (mt == MAP_UP) { const int t = n >> 8, c = n & 255; return c < 128 ? t * 128 + c : DFF + t * 128 + (c - 128); }
    if (mt == MAP_UKV) { const int c = n & 255, hh = c >> 6, d = c & 63; return hh * 128 + d + (n >= 256 ? 64 : 0); }
    if (mt == MAP_UQ) { if (n >= 384) return -1; const int hh = n / 96, w = n % 96; if (w < 64) return hh * 96 + w; const int q = w - 64; return hh * 96 + 64 + (q >> 1) + 16 * (q & 1); }
    const int t = n >> 8, c = n & 255;
    switch (t) {
        case 0: case 1: { const int hh = c >> 6, q = c & 63; return OFF_A + t * 256 + hh * 64 + (q >> 1) + 32 * (q & 1); }
        case 2: return OFF_A + 512 + c;
        case 3: case 4: { const int sub = c >> 5, q = c & 31; return OFF_C + (t - 3) * 256 + sub * 32 + (q >> 1) + 16 * (q & 1); }
        case 5: return OFF_C + 512 + c;
        case 6: case 7: case 8: return OFF_D + (t - 6) * 256 + c;
        case 9: return OFF_B + c;
        case 10: { if (c < 128) return OFF_B + 256 + c; if (c < 160) { const int q = c - 128; return OFF_B + 640 + (q >> 1) + 16 * (q & 1); } return -1; }
        default: return OFF_B + 384 + c;
    }
}

template <bool THROUGH>
__device__ __forceinline__ void transpose_item(const float* W, int K, int N, const float* gain, bf16* WT, int mt, int nblk, LAS float* scr, int item, int lane) {
    const int kb = item / nblk, nb = item % nblk, k0 = 64 * kb, n0 = 32 * nb;
    const int src = map_col(mt, n0 + (lane & 31));
    float v[32];
#pragma unroll
    for (int i = 0; i < 32; ++i) { const int kk = 2 * i + (lane >> 5); v[i] = (src >= 0) ? W[(size_t)(k0 + kk) * N + src] : 0.f; }
#pragma unroll
    for (int i = 0; i < 32; ++i) { const int kk = 2 * i + (lane >> 5); float x = v[i]; if (gain && src >= 0) x *= gain[k0 + kk]; scr[kk * 33 + (lane & 31)] = x; }
    LDS_WAIT(); asm volatile("" ::: "memory");
    const int c = lane & 7;
#pragma unroll
    for (int j = 0; j < 4; ++j) { const int n = (lane >> 3) + 8 * j; const LAS float* s = scr + (8 * c) * 33 + n;
        v4u o; o.x = pk2(s[0 * 33], s[1 * 33]); o.y = pk2(s[2 * 33], s[3 * 33]); o.z = pk2(s[4 * 33], s[5 * 33]); o.w = pk2(s[6 * 33], s[7 * 33]);
        if (THROUGH) asm volatile("global_store_dwordx4 %0, %1, off sc1" :: "v"(WT + (size_t)(n0 + n) * K + k0 + 8 * c), "v"(o) : "memory"); else *(GAS v4u*)(WT + (size_t)(n0 + n) * K + k0 + 8 * c) = o; }
    LDS_WAIT(); asm volatile("" ::: "memory");
}

namespace epi {
using pg8::f32x4; using pg8::u32x4; using pg8::Unit; using pg8::bf16_t;
constexpr int BM = 256, HALF = 128;

__device__ __forceinline__ u32x4 pack8(const f32x4& a, const f32x4& b) {
    u32x4 w; w.x = cvt_pk_bf16(a[0], a[1]); w.y = cvt_pk_bf16(a[2], a[3]); w.z = cvt_pk_bf16(b[0], b[1]); w.w = cvt_pk_bf16(b[2], b[3]); return w;
}
__device__ __forceinline__ void rope8(f32x4& a, f32x4& b, const f32x4& cs01, const f32x4& cs23) {
    const float a0 = a[0] * cs01[0] - a[1] * cs01[1], a1 = a[0] * cs01[1] + a[1] * cs01[0];
    const float a2 = a[2] * cs01[2] - a[3] * cs01[3], a3 = a[2] * cs01[3] + a[3] * cs01[2];
    const float b0 = b[0] * cs23[0] - b[1] * cs23[1], b1 = b[0] * cs23[1] + b[1] * cs23[0];
    const float b2 = b[2] * cs23[2] - b[3] * cs23[3], b3 = b[2] * cs23[3] + b[3] * cs23[2];
    a = (f32x4){a0, a1, a2, a3}; b = (f32x4){b0, b1, b2, b3};
}
__device__ __forceinline__ void rot_step(f32x4& t, const f32x4& d) {
    const float c0 = t[0] * d[0] - t[1] * d[1], s0 = t[1] * d[0] + t[0] * d[1], c1 = t[2] * d[2] - t[3] * d[3], s1 = t[3] * d[2] + t[2] * d[3];
    t = (f32x4){c0, s0, c1, s1};
}
__device__ __forceinline__ float sumsq8(const f32x4& a, const f32x4& b) { return (a[0] * a[0] + a[1] * a[1]) + (a[2] * a[2] + a[3] * a[3]) + (b[0] * b[0] + b[1] * b[1]) + (b[2] * b[2] + b[3] * b[3]); }
__device__ __forceinline__ float red_fq(float s) {
    auto a = __builtin_amdgcn_permlane16_swap(__float_as_uint(s), __float_as_uint(s), false, false); s = __uint_as_float(a[0]) + __uint_as_float(a[1]);
    auto b = __builtin_amdgcn_permlane32_swap(__float_as_uint(s), __float_as_uint(s), false, false); return __uint_as_float(b[0]) + __uint_as_float(b[1]);
}
__device__ __forceinline__ float sum16(const float* p) { const f32x4 a = *(const f32x4*)p, b = *(const f32x4*)(p + 4), c = *(const f32x4*)(p + 8), d = *(const f32x4*)(p + 12);
    return ((a[0] + a[1]) + (a[2] + a[3])) + ((b[0] + b[1]) + (b[2] + b[3])) + ((c[0] + c[1]) + (c[2] + c[3])) + ((d[0] + d[1]) + (d[2] + d[3])); }

__device__ __forceinline__ float row_ssq(const float* ssq, int row, int fq) { const f32x4 a = *(const f32x4*)(ssq + (size_t)row * 16 + 4 * fq); return red_fq((a[0] + a[1]) + (a[2] + a[3])); }

template <int MSTEP = 16>
__device__ __forceinline__ void batch_rs(float (&rs)[8], const float* ssq, int stride, int nq, int row0, int fq, float num, float inv_dim) {
    f32x4 v[8];
#pragma unroll
    for (int i = 0; i < 8; ++i) v[i] = (fq < nq) ? *(const f32x4*)(ssq + (size_t)(row0 + (i >> 2) * HALF + (i & 3) * MSTEP) * stride + 4 * fq) : (f32x4){0.f, 0.f, 0.f, 0.f};
#pragma unroll
    for (int i = 0; i < 8; ++i) rs[i] = num / sqrtf(red_fq((v[i][0] + v[i][1]) + (v[i][2] + v[i][3])) * inv_dim + NORM_EPS);
}

struct EpiIn {
    static constexpr bool PERM = true, AFTER_DRAIN = false, STAGED = true, AROWPERM = false;
    unsigned char* ws; PG8_LAS float* rsl;
    struct Carry { int pm; };
    __device__ __forceinline__ void stage(const Unit&, int, int, int) const {}
    template <int MODE>
    __device__ __forceinline__ void body(const f32x4 (&acc)[2][2][4][2], const Unit& u, int wr, int wc, size_t doff, int ld, int coff, float sc, Carry& cy) const {
        const float* cs64 = (const float*)(ws + WS_TAB64); const float* cs32 = (const float*)(ws + WS_TAB32);
        float* ssq_cq = (float*)(ws + WS_SSQCQ); float* ssq_ckv = (float*)(ws + WS_SSQCKV); bf16_t* KB = (bf16_t*)(ws + X_KB);
        bf16_t* dst = (bf16_t*)(ws + doff);
        const int lane_ = pg8::lane_now(), fr_ = lane_ & 15, fq = lane_ >> 4; const int row0 = u.pm * BM + wr * 64 + fr_;
        float rs[8]; { PG8_LAS float* rsw = rsl + ((wr * 4 + wc) * 128 + fr_);
          if (cy.pm != u.pm) { batch_rs(rs, (const float*)(ws + WS_SSQA), 16, 4, row0, fq, 1.0f, 1.0f / DMODEL); cy.pm = u.pm;
              if (fq == 0) {
#pragma unroll
                  for (int it = 0; it < 8; ++it) rsw[it * 16] = rs[it]; } }
          else {
#pragma unroll
              for (int it = 0; it < 8; ++it) rs[it] = rsw[it * 16]; }
#pragma unroll
          for (int it = 0; it < 8; ++it) rs[it] *= sc; }
        constexpr bool rope = (MODE == 1 || MODE == 2 || MODE == 4);
        const float* tab = (MODE == 1) ? cs64 : cs32; constexpr int tw = (MODE == 1) ? 32 : 16;
        int j0[2];
#pragma unroll
        for (int bj = 0; bj < 2; ++bj) { const int ct = bj * HALF + wc * 32 + 8 * fq; j0[bj] = (MODE == 1) ? ((ct & 63) >> 1) : (MODE == 2) ? ((ct & 31) >> 1) : 4 * fq; }
        f32x4 T[2][4], D[4];
        if constexpr (rope) {
#pragma unroll
            for (int bj = 0; bj < 2; ++bj) {
                if (MODE == 4 && bj == 0) continue;
#pragma unroll
                for (int ai = 0; ai < 2; ++ai) { const float* tp = tab + ((size_t)((row0 + ai * HALF) & (SEQ - 1)) * tw + j0[bj]) * 2; T[ai][2 * bj] = *(const f32x4*)tp; T[ai][2 * bj + 1] = *(const f32x4*)(tp + 4); }
                const float* dp = tab + ((size_t)16 * tw + j0[bj]) * 2; D[2 * bj] = *(const f32x4*)dp; D[2 * bj + 1] = *(const f32x4*)(dp + 4);
            }
        }
#pragma unroll
        for (int it = 0; it < 8; ++it) {
            const int ai = it >> 2, m = it & 3;
            const int row = row0 + ai * HALF + m * 16;
            float ss = 0.f;
#pragma unroll
            for (int bj = 0; bj < 2; ++bj) {
                const int ct = bj * HALF + wc * 32 + 8 * fq;
                f32x4 a = acc[ai][bj][m][0] * rs[it], b = acc[ai][bj][m][1] * rs[it];
                if constexpr (MODE == 1 || MODE == 2) rope8(a, b, T[ai][2 * bj], T[ai][2 * bj + 1]);
                if (MODE == 4 && bj == 1) {
                    if (wc == 0) {
                        rope8(a, b, T[ai][2], T[ai][3]);
                        const u32x4 w = pack8(a, b);
#pragma unroll
                        for (int hh = 0; hh < 4; ++hh) *(u32x4*)(KB + (size_t)row * 384 + hh * 96 + 64 + 8 * fq) = w;
                    }
                } else {
                    if constexpr (MODE >= 3) ss += sumsq8(a, b);
                    const int cc = (MODE == 4) ? (wc * 32 + 8 * fq) : ct;
                    *(u32x4*)(dst + (size_t)row * ld + coff + cc) = pack8(a, b);
                }
            }
            if constexpr (MODE >= 3) { ss = red_fq(ss);
                if (fq == 0) { if (MODE == 3) ssq_cq[(size_t)row * 8 + wc] = ss; else if (MODE == 4) ssq_cq[(size_t)row * 8 + 4 + wc] = ss; else ssq_ckv[(size_t)row * 4 + wc] = ss; } }
            if constexpr (rope) { if (m < 3) {
#pragma unroll
                for (int k = (MODE == 4 ? 2 : 0); k < 4; ++k) rot_step(T[ai][k], D[k]); } }
            asm volatile("" ::: "memory");
        }
    }
    __device__ __forceinline__ void operator()(const f32x4 (&acc)[2][2][4][2], const Unit& u, int wr, int wc, int fr, int fq, Carry& cy, int) const {
        switch (u.pn) {
            case 0: body<1>(acc, u, wr, wc, X_QO, 1024, 0, SC_A, cy); break;
            case 1: body<1>(acc, u, wr, wc, X_KA, 256, 0, 1.f, cy); break;
            case 2: body<0>(acc, u, wr, wc, X_VA, 256, 0, 1.f, cy); break;
            case 3: body<2>(acc, u, wr, wc, X_QO, 1024, 512, SC_C, cy); break;
            case 4: body<2>(acc, u, wr, wc, X_KC, 256, 0, 1.f, cy); break;
            case 5: body<0>(acc, u, wr, wc, X_VC, 256, 0, 1.f, cy); break;
            case 6: body<0>(acc, u, wr, wc, X_QO, 1024, 768, SC_D, cy); break;
            case 7: body<0>(acc, u, wr, wc, X_KD, 256, 0, 1.f, cy); break;
            case 8: body<0>(acc, u, wr, wc, X_VD, 256, 0, 1.f, cy); break;
            case 9: body<3>(acc, u, wr, wc, X_CQ, 384, 0, 1.f, cy); break;
            case 10: body<4>(acc, u, wr, wc, X_CQ, 384, 256, 1.f, cy); break;
            default: body<5>(acc, u, wr, wc, X_CKV, 256, 0, 1.f, cy); break;
        }
    }
};

struct EpiMla {
    static constexpr bool PERM = true, AFTER_DRAIN = false, STAGED = false, AROWPERM = false; struct Carry {};
    int mode; unsigned char* ws;
    __device__ __forceinline__ void operator()(const f32x4 (&acc)[2][2][4][2], const Unit& u, int wr, int wc, int fr, int fq) const {
        const float* cs32 = (const float*)(ws + WS_TAB32);
        bf16_t* QB = (bf16_t*)(ws + X_QB); bf16_t* KB = (bf16_t*)(ws + X_KB); bf16_t* VB = (bf16_t*)(ws + X_VB);
        const int lane_ = pg8::lane_now(), fr_ = lane_ & 15; fq = lane_ >> 4; const int row0 = u.pm * BM + wr * 64 + fr_;
        float rs[8];
        if (mode == 0) batch_rs(rs, (const float*)(ws + WS_SSQCQ), 8, 2, row0, fq, SC_B, 1.0f / 384.0f); else batch_rs(rs, (const float*)(ws + WS_SSQCKV), 4, 1, row0, fq, 1.0f, 1.0f / 256.0f);
        f32x4 T[2][4], D[4]; bool rot[2];
#pragma unroll
        for (int bj = 0; bj < 2; ++bj) { const int c8 = u.pn * BM + bj * HALF + wc * 32 + 8 * fq, w = c8 % 96; rot[bj] = (mode == 0) && c8 < 384 && w >= 64; const int j0 = rot[bj] ? ((w - 64) >> 1) : 0;
#pragma unroll
            for (int ai = 0; ai < 2; ++ai) { const float* tp = cs32 + ((size_t)((row0 + ai * HALF) & (SEQ - 1)) * 16 + j0) * 2;
                if (mode == 0) { T[ai][2 * bj] = *(const f32x4*)tp; T[ai][2 * bj + 1] = *(const f32x4*)(tp + 4); } else { T[ai][2 * bj] = (f32x4){1.f, 0.f, 1.f, 0.f}; T[ai][2 * bj + 1] = (f32x4){1.f, 0.f, 1.f, 0.f}; } }
            const float* dp = cs32 + ((size_t)16 * 16 + j0) * 2;
            if (mode == 0) { D[2 * bj] = *(const f32x4*)dp; D[2 * bj + 1] = *(const f32x4*)(dp + 4); } else { D[2 * bj] = (f32x4){1.f, 0.f, 1.f, 0.f}; D[2 * bj + 1] = (f32x4){1.f, 0.f, 1.f, 0.f}; } }
#pragma unroll
        for (int it = 0; it < 8; ++it) {
            const int ai = it >> 2, m = it & 3;
            const int row = row0 + ai * HALF + m * 16;
#pragma unroll
            for (int bj = 0; bj < 2; ++bj) {
                const int c8 = u.pn * BM + bj * HALF + wc * 32 + 8 * fq;
                f32x4 a = acc[ai][bj][m][0] * rs[it], b = acc[ai][bj][m][1] * rs[it];
                if (mode == 0) {
                    if (c8 < 384) {
                        f32x4 ra = a, rb = b; rope8(ra, rb, T[ai][2 * bj], T[ai][2 * bj + 1]);
                        if (rot[bj]) { a = ra; b = rb; }
                        *(u32x4*)(QB + (size_t)row * 384 + c8) = pack8(a, b);
                    }
                } else if (u.pn == 0) { const int hh = c8 >> 6, d = c8 & 63; *(u32x4*)(KB + (size_t)row * 384 + hh * 96 + d) = pack8(a, b); }
                else *(u32x4*)(VB + (size_t)row * 256 + (c8 - 256)) = pack8(a, b);
            }
            if (mode == 0 && m < 3) {
#pragma unroll
                for (int k = 0; k < 4; ++k) rot_step(T[ai][k], D[k]); }
            if (it & 1) asm volatile("" ::: "memory");
        }
    }
};

__device__ __forceinline__ void unpack8(const u32x4& w, f32x4& a, f32x4& b) { a = (f32x4){bflo(w.x), bfhi(w.x), bflo(w.y), bfhi(w.y)}; b = (f32x4){bflo(w.z), bfhi(w.z), bflo(w.w), bfhi(w.w)}; }
struct EpiRes {
    static constexpr bool PERM = true, AFTER_DRAIN = false, STAGED = false, AROWPERM = false; struct Carry {};
    const bf16_t* hin; bf16_t* hout; float* ssq; bool dry;
    __device__ __forceinline__ void operator()(const f32x4 (&acc)[2][2][4][2], const Unit& u, int wr, int wc, int fr, int fq) const {
        const int lane_ = pg8::lane_now(), fr_ = lane_ & 15; fq = lane_ >> 4; const int row0 = u.pm * BM + wr * 64 + fr_;
        const int c0 = u.pn * BM + wc * 32 + 8 * fq;
        u32x4 H[8][2];
#pragma unroll
        for (int it = 0; it < 8; ++it)
#pragma unroll
            for (int bj = 0; bj < 2; ++bj) H[it][bj] = *(const u32x4*)(hin + (size_t)(row0 + (it >> 2) * HALF + (it & 3) * 16) * DMODEL + c0 + bj * HALF);
#pragma unroll
        for (int it = 0; it < 8; ++it) {
            const int ai = it >> 2, m = it & 3;
            const int row = row0 + ai * HALF + m * 16;
            float ss = 0.f;
#pragma unroll
            for (int bj = 0; bj < 2; ++bj) {
                f32x4 a, b; unpack8(H[it][bj], a, b);
                a = a + acc[ai][bj][m][0]; b = b + acc[ai][bj][m][1];
                if (!dry) *(u32x4*)(hout + (size_t)row * DMODEL + c0 + bj * HALF) = pack8(a, b);
                ss += sumsq8(a, b);
            }
            ss = red_fq(ss);
            if (dry) asm volatile("" :: "v"(ss)); else if (fq == 0) ssq[(size_t)row * 16 + u.pn * 4 + wc] = ss;
            asm volatile("" ::: "memory");
        }
    }
};

struct EpiSpill {
    static constexpr bool PERM = true, AFTER_DRAIN = false, STAGED = false, AROWPERM = false; struct Carry {};
    bf16_t* esc_base;
    __device__ __forceinline__ void operator()(const f32x4 (&acc)[2][2][4][2], const Unit& u, int wr, int wc, int fr, int fq) const {
        const int tid = ((wr * 4 + wc) << 6) | pg8::lane_now();
        bf16_t* esc = esc_base + (size_t)((u.pm >> 3) * 32 + u.pn * 8 + (u.pm & 7)) * 65536;
#pragma unroll
        for (int ai = 0; ai < 2; ++ai)
#pragma unroll
            for (int m = 0; m < 4; ++m)
#pragma unroll
                for (int bj = 0; bj < 2; ++bj)
                    *(u32x4*)(esc + ((size_t)(((ai * 2 + bj) * 4 + m) * NTHREADS + tid)) * 8) = pack8(acc[ai][bj][m][0], acc[ai][bj][m][1]);
    }
};
struct EpiPle {
    static constexpr bool PERM = true, AFTER_DRAIN = false, STAGED = false, AROWPERM = false; struct Carry {};
    const float* ssq; const bf16_t* esc; const bf16_t* hin; bf16_t* hout; float* ssq_out; bool dry;
    __device__ __forceinline__ void operator()(const f32x4 (&acc)[2][2][4][2], const Unit& u, int wr, int wc, int fr, int fq) const {
        const int lane_ = pg8::lane_now(), fr_ = lane_ & 15; const int tid = ((wr * 4 + wc) << 6) | lane_; fq = lane_ >> 4; const int row0 = u.pm * BM + wr * 64 + fr_;
        const int c0 = u.pn * BM + wc * 32 + 8 * fq;
        float rs[8]; batch_rs(rs, ssq, 16, 4, row0, fq, -LOG2E, 1.0f / DMODEL);
#pragma unroll
        for (int ai = 0; ai < 2; ++ai) {
            u32x4 H[4][2], E[4][2];
#pragma unroll
            for (int m = 0; m < 4; ++m)
#pragma unroll
                for (int bj = 0; bj < 2; ++bj) { H[m][bj] = *(const u32x4*)(hin + (size_t)(row0 + ai * HALF + m * 16) * DMODEL + c0 + bj * HALF);
                    E[m][bj] = *(const u32x4*)(esc + ((size_t)(((ai * 2 + bj) * 4 + m) * NTHREADS + tid)) * 8); }
#pragma unroll
            for (int m = 0; m < 4; ++m) {
                const int it = ai * 4 + m, row = row0 + ai * HALF + m * 16;
                float ss = 0.f;
#pragma unroll
                for (int bj = 0; bj < 2; ++bj) {
                    f32x4 a, b, ea, eb; unpack8(H[m][bj], a, b); unpack8(E[m][bj], ea, eb);
                    const f32x4 ga = acc[ai][bj][m][0] * rs[it], gb = acc[ai][bj][m][1] * rs[it];
#pragma unroll
                    for (int e = 0; e < 4; ++e) { a[e] += ea[e] * fast_rcp(1.0f + fast_exp2(ga[e])); b[e] += eb[e] * fast_rcp(1.0f + fast_exp2(gb[e])); }
                    if (!dry) *(u32x4*)(hout + (size_t)row * DMODEL + c0 + bj * HALF) = pack8(a, b);
                    ss += sumsq8(a, b);
                }
                ss = red_fq(ss);
                if (dry) asm volatile("" :: "v"(ss)); else if (fq == 0) ssq_out[(size_t)row * 16 + u.pn * 4 + wc] = ss;
                asm volatile("" ::: "memory");
            }
        }
    }
};

template <int CTRL> __device__ __forceinline__ float dpp(float old, float src) {
    return __int_as_float(__builtin_amdgcn_update_dpp(__float_as_int(old), __float_as_int(src), CTRL, 0xf, 0xf, false));
}
template <int NEXT> __device__ __forceinline__ float dpp_rot(float src) { float d;
    if (NEXT) asm("v_mov_b32_dpp %0, %1 row_ror:15 row_mask:0xf bank_mask:0xf" : "=v"(d) : "v"(src)); else asm("v_mov_b32_dpp %0, %1 row_ror:1 row_mask:0xf bank_mask:0xf" : "=v"(d) : "v"(src));
    return d; }
template <int NEXT> __device__ __forceinline__ float dpp_into(float old, float src) { float d;
    if (NEXT) asm("v_mov_b32_dpp %0, %2 row_shl:1 row_mask:0xf bank_mask:0xf" : "=v"(d) : "0"(old), "v"(src)); else asm("v_mov_b32_dpp %0, %2 row_shr:1 row_mask:0xf bank_mask:0xf" : "=v"(d) : "0"(old), "v"(src));
    return d; }
struct EpiUpConv {
    static constexpr bool PERM = true, AFTER_DRAIN = false, STAGED = true, AROWPERM = true;
    const float* ssq; bf16_t* act; float* halo; const float* cw; const float* cb; PG8_LAS float* xl; PG8_LAS float* cwl; PG8_LAS float* rsl;
    struct Carry { int pm; };
    __device__ __forceinline__ void stage(const Unit& u, int buf, int wid, int lane) const {
        if (wid < 4) {
            const int kind = 2 * wid + (lane >> 5), k3 = kind & 3, col = (kind >= 4 ? DFF : 0) + u.pn * HALF + (lane & 31) * 4;
            const float* src = (k3 == 3) ? cb + col : cw + (size_t)k3 * NUP + col;
            __builtin_amdgcn_global_load_lds((const unsigned*)src, (PG8_LAS unsigned*)(cwl + buf * 1024 + wid * 256), 16, 0, 0);
        }
    }
    __device__ __forceinline__ void operator()(f32x4 (&acc)[2][2][4][2], const Unit& u, int wr, int wc, int fr, int fq, Carry& cy, int buf) const {
        const int lane_ = pg8::lane_now(), fr_ = lane_ & 15; fq = lane_ >> 4; const int row0 = u.pm * BM + wr * 64 + 4 * fr_;
        const int ct = wc * 32 + 8 * fq;
        { float rs[8]; PG8_LAS float* rsw = rsl + ((wr * 4 + wc) * 128 + fr_);
          if (cy.pm != u.pm) { batch_rs<1>(rs, ssq, 16, 4, row0, fq, 1.0f, 1.0f / DMODEL); cy.pm = u.pm;
              if (fq == 0) {
#pragma unroll
                  for (int it = 0; it < 8; ++it) rsw[it * 16] = rs[it]; } }
          else {
#pragma unroll
              for (int it = 0; it < 8; ++it) rs[it] = rsw[it * 16]; }
#pragma unroll
          for (int it = 0; it < 8; ++it)
#pragma unroll
              for (int bj = 0; bj < 2; ++bj) { acc[it >> 2][bj][it & 3][0] *= rs[it]; acc[it >> 2][bj][it & 3][1] *= rs[it]; } }
#pragma unroll
        for (int ai = 0; ai < 2; ++ai)
#pragma unroll
            for (int bj = 0; bj < 2; ++bj)
                asm volatile("" : "+v"(acc[ai][bj][0][0]), "+v"(acc[ai][bj][0][1]), "+v"(acc[ai][bj][1][0]), "+v"(acc[ai][bj][1][1]), "+v"(acc[ai][bj][2][0]), "+v"(acc[ai][bj][2][1]), "+v"(acc[ai][bj][3][0]), "+v"(acc[ai][bj][3][1]));
        f32x4 CW[2][8];
#pragma unroll
        for (int n = 0; n < 2; ++n)
#pragma unroll
            for (int k = 0; k < 8; ++k) CW[n][k] = *(const PG8_LAS f32x4*)(cwl + buf * 1024 + k * 128 + ct + 4 * n);
#pragma unroll
        for (int ai = 0; ai < 2; ++ai) {
            const int q = 2 * ai + wr;
#pragma unroll
            for (int bj = 0; bj < 2; ++bj)
#pragma unroll
                for (int n = 0; n < 2; ++n) {
                    if (fr_ == 0) *(PG8_LAS f32x4*)(xl + (q * 2 + 0) * 256 + bj * HALF + ct + 4 * n) = acc[ai][bj][0][n];
                    if (fr_ == 15) *(PG8_LAS f32x4*)(xl + (q * 2 + 1) * 256 + bj * HALF + ct + 4 * n) = acc[ai][bj][3][n];
                    if (q == 0 && fr_ == 0) { *(f32x4*)(halo + ((size_t)u.pm * 4 + 0) * NUP + u.pn * BM + bj * HALF + ct + 4 * n) = acc[ai][bj][0][n];
                                              *(f32x4*)(halo + ((size_t)u.pm * 4 + 1) * NUP + u.pn * BM + bj * HALF + ct + 4 * n) = acc[ai][bj][1][n]; }
                    if (q == 3 && fr_ == 15) { *(f32x4*)(halo + ((size_t)u.pm * 4 + 2) * NUP + u.pn * BM + bj * HALF + ct + 4 * n) = acc[ai][bj][2][n];
                                               *(f32x4*)(halo + ((size_t)u.pm * 4 + 3) * NUP + u.pn * BM + bj * HALF + ct + 4 * n) = acc[ai][bj][3][n]; }
                }
        }
        asm volatile("s_waitcnt lgkmcnt(0)" ::: "memory"); __builtin_amdgcn_s_barrier(); asm volatile("" ::: "memory");
#pragma unroll
        for (int ai = 0; ai < 2; ++ai) {
            const int q = 2 * ai + wr;
            const f32x4 zero = (f32x4){0.f, 0.f, 0.f, 0.f};
            f32x4 hpg[2], hpv[2], hng[2], hnv[2];
#pragma unroll
            for (int n = 0; n < 2; ++n) { hpg[n] = (q > 0) ? *(const PG8_LAS f32x4*)(xl + ((q - 1) * 2 + 1) * 256 + ct + 4 * n) : zero; hpv[n] = (q > 0) ? *(const PG8_LAS f32x4*)(xl + ((q - 1) * 2 + 1) * 256 + HALF + ct + 4 * n) : zero; }
#pragma unroll
            for (int m = 0; m < 4; ++m) {
                if (m == 2) {
#pragma unroll
                    for (int n = 0; n < 2; ++n) { hng[n] = (q < 3) ? *(const PG8_LAS f32x4*)(xl + ((q + 1) * 2 + 0) * 256 + ct + 4 * n) : zero; hnv[n] = (q < 3) ? *(const PG8_LAS f32x4*)(xl + ((q + 1) * 2 + 0) * 256 + HALF + ct + 4 * n) : zero; }
                }
                u32x4 w;
#pragma unroll
                for (int n = 0; n < 2; ++n) {
                    const f32x4 g0 = CW[n][0], g1 = CW[n][1], g2 = CW[n][2], gb = CW[n][3], v0 = CW[n][4], v1 = CW[n][5], v2 = CW[n][6], vb = CW[n][7];
#pragma unroll
                    for (int ep = 0; ep < 2; ++ep) {
                        const int e0 = 2 * ep, e1 = e0 + 1;
                        const pg8::f32x2 cg2 = {acc[ai][0][m][n][e0], acc[ai][0][m][n][e1]}, cv2 = {acc[ai][1][m][n][e0], acc[ai][1][m][n][e1]};
                        pg8::f32x2 pg2, pv2, ng2, nv2;
                        if (m == 0) { pg2.x = dpp_into<0>(hpg[n][e0], acc[ai][0][3][n][e0]); pg2.y = dpp_into<0>(hpg[n][e1], acc[ai][0][3][n][e1]); pv2.x = dpp_into<0>(hpv[n][e0], acc[ai][1][3][n][e0]); pv2.y = dpp_into<0>(hpv[n][e1], acc[ai][1][3][n][e1]); }
                        else { pg2 = (pg8::f32x2){acc[ai][0][m > 0 ? m - 1 : 0][n][e0], acc[ai][0][m > 0 ? m - 1 : 0][n][e1]}; pv2 = (pg8::f32x2){acc[ai][1][m > 0 ? m - 1 : 0][n][e0], acc[ai][1][m > 0 ? m - 1 : 0][n][e1]}; }
                        if (m == 3) { ng2.x = dpp_into<1>(hng[n][e0], acc[ai][0][0][n][e0]); ng2.y = dpp_into<1>(hng[n][e1], acc[ai][0][0][n][e1]); nv2.x = dpp_into<1>(hnv[n][e0], acc[ai][1][0][n][e0]); nv2.y = dpp_into<1>(hnv[n][e1], acc[ai][1][0][n][e1]); }
                        else { ng2 = (pg8::f32x2){acc[ai][0][m < 3 ? m + 1 : 3][n][e0], acc[ai][0][m < 3 ? m + 1 : 3][n][e1]}; nv2 = (pg8::f32x2){acc[ai][1][m < 3 ? m + 1 : 3][n][e0], acc[ai][1][m < 3 ? m + 1 : 3][n][e1]}; }
                        const pg8::f32x2 x2 = (pg8::f32x2){gb[e0], gb[e1]} + (pg8::f32x2){g0[e0], g0[e1]} * pg2 + (pg8::f32x2){g1[e0], g1[e1]} * cg2 + (pg8::f32x2){g2[e0], g2[e1]} * ng2;
                        const pg8::f32x2 y2 = (pg8::f32x2){vb[e0], vb[e1]} + (pg8::f32x2){v0[e0], v0[e1]} * pv2 + (pg8::f32x2){v1[e0], v1[e1]} * cv2 + (pg8::f32x2){v2[e0], v2[e1]} * nv2;
                        constexpr float KG = -2.0f * LOG2E * 0.7978845608028654f;
                        const pg8::f32x2 a2 = x2 * ((x2 * x2) * (pg8::f32x2){KG * 0.044715f, KG * 0.044715f} + (pg8::f32x2){KG, KG});
                        const pg8::f32x2 d2 = (pg8::f32x2){fast_exp2(a2.x), fast_exp2(a2.y)} + (pg8::f32x2){1.0f, 1.0f};
                        const pg8::f32x2 o2 = (x2 * (pg8::f32x2){fast_rcp(d2.x), fast_rcp(d2.y)}) * y2;
                        const unsigned pk = cvt_pk_bf16(o2.x, o2.y);
                        if (n == 0) { if (ep == 0) w.x = pk; else w.y = pk; } else { if (ep == 0) w.z = pk; else w.w = pk; }
                    }
                }
                *(u32x4*)(act + (size_t)(row0 + ai * HALF + m) * DFF + u.pn * HALF + ct) = w;
            }
            asm volatile("" ::: "memory");
        }
    }
};
}

struct Frame {
    LAS unsigned char* lds;
    int tid, lane, wave, vcu, G;
    unsigned char* ws;
};
#define FRAME_TID(F_) Frame F = F_; { const int l_ = pg8::lane_now(); F.lane = l_; F.tid = (F.wave << 6) | l_; }
#define WSP(T, off) ((T*)(F.ws + (off)))

template <bool THROUGH>
__device__ __forceinline__ void convert_layer_weights(const Frame& F, const ArgView& A, int l, int gw, int NGW) {
    LAS float* scr = (LAS float*)(F.lds + F.wave * 16384);
    constexpr int I_1 = (1024 / 64) * (N1 / 32), I_UP = (1024 / 64) * (NUP / 32), I_DN = (DFF / 64) * (1024 / 32), I_O = 16 * 32, I_G = 16 * 32, I_PP = 4 * 32, I_UQ = 6 * 16, I_UKV = 4 * 16;
    constexpr int NIT = I_1 + I_UP + I_DN + I_O + I_G + I_PP + I_UQ + I_UKV;
    unsigned char* wl = F.ws + WS_W + (size_t)l * W_STRIDE;
    for (int it = gw; it < NIT; it += NGW) {
        int r = it;
        if (r < I_1) { transpose_item<THROUGH>(A.in(I_W_IN) + (size_t)l * 1024 * IN_COLS, 1024, IN_COLS, A.in(I_ATTN_NORM) + l * 1024, (bf16*)(wl + W_1T), MAP_IN, N1 / 32, scr, r, F.lane); continue; } r -= I_1;
        if (r < I_UP) { transpose_item<THROUGH>(A.in(I_W_UP) + (size_t)l * 1024 * NUP, 1024, NUP, A.in(I_FFN_NORM) + l * 1024, (bf16*)(wl + W_UPT), MAP_UP, NUP / 32, scr, r, F.lane); continue; } r -= I_UP;
        if (r < I_DN) { transpose_item<THROUGH>(A.in(I_W_DOWN) + (size_t)l * DFF * 1024, DFF, 1024, nullptr, (bf16*)(wl + W_DNT), MAP_ID, 32, scr, r, F.lane); continue; } r -= I_DN;
        if (r < I_O) { transpose_item<THROUGH>(A.in(I_W_O) + (size_t)l * 1024 * 1024, 1024, 1024, nullptr, (bf16*)(wl + W_OT), MAP_ID, 32, scr, r, F.lane); continue; } r -= I_O;
        if (r < I_G) { transpose_item<THROUGH>(A.in(I_W_G) + (size_t)l * 1024 * 1024, 1024, 1024, A.in(I_PLE_NORM) + l * 1024, (bf16*)(wl + W_GT), MAP_ID, 32, scr, r, F.lane); continue; } r -= I_G;
        if (r < I_PP) { transpose_item<THROUGH>(A.in(I_W_PP) + (size_t)l * 256 * 1024, 256, 1024, nullptr, (bf16*)(wl + W_PPT), MAP_ID, 32, scr, r, F.lane); continue; } r -= I_PP;
        if (r < I_UQ) { transpose_item<THROUGH>(A.in(I_W_UQ) + (size_t)l * 384 * 384, 384, 384, A.in(I_QNORM) + l * 384, (bf16*)(wl + W_UQT), MAP_UQ, 16, scr, r, F.lane); continue; } r -= I_UQ;
        transpose_item<THROUGH>(A.in(I_W_UKV) + (size_t)l * 256 * 512, 256, 512, A.in(I_KVNORM) + l * 256, (bf16*)(wl + W_UKVT), MAP_UKV, 16, scr, r, F.lane);
    }
}
__device__ __forceinline__ void convert_next_layer(const Frame& F0, const ArgView& A, int lnext, int idx, int n) {
    FRAME_TID(F0);
    convert_layer_weights<true>(F, A, lnext, idx * NWAVES + F.wave, n * NWAVES);
    asm volatile("s_waitcnt vmcnt(0) lgkmcnt(0)" ::: "memory");
    __syncthreads();
}
__device__ __forceinline__ void prologue_phase(const Frame& F0, const ArgView& A) {
    FRAME_TID(F0);
    const int gw = F.vcu * NWAVES + F.wave, NGW = F.G * NWAVES;
    convert_layer_weights<false>(F, A, 0, gw, NGW);
    {
        const float* src = A.in(I_X); bf16* hb = WSP(bf16, WS_HBA); float* ssq = WSP(float, WS_SSQA);
        for (int m0 = 4 * gw; m0 < M; m0 += 4 * NGW) {
            f32x4 v[4][4];
#pragma unroll
            for (int u = 0; u < 4; ++u) { const GAS f32x4* xr = (const GAS f32x4*)(src + (size_t)(m0 + u) * DMODEL) + F.lane;
#pragma unroll
                for (int j = 0; j < 4; ++j) v[u][j] = xr[64 * j]; }
#pragma unroll
            for (int u = 0; u < 4; ++u) { const int m = m0 + u; float s = 0.f;
#pragma unroll
                for (int j = 0; j < 4; ++j) s += (v[u][j].x * v[u][j].x + v[u][j].y * v[u][j].y) + (v[u][j].z * v[u][j].z + v[u][j].w * v[u][j].w);
                s = wave_sum(s);
                GAS unsigned long long* o8 = (GAS unsigned long long*)(hb + (size_t)m * DMODEL) + F.lane;
#pragma unroll
                for (int j = 0; j < 4; ++j) o8[64 * j] = (unsigned long long)pk2(v[u][j].x, v[u][j].y) | ((unsigned long long)pk2(v[u][j].z, v[u][j].w) << 32);
                if (F.lane < 16) ssq[(size_t)m * 16 + F.lane] = (F.lane == 0) ? s : 0.f; }
        }
    }
    {
        const int gt = F.vcu * NTHREADS + F.tid, NT = F.G * NTHREADS;
        float* t64 = WSP(float, WS_TAB64); float* t32 = WSP(float, WS_TAB32);
        for (int i = gt; i < SEQ * 48; i += NT) {
            const int pos = i / 48, j = i % 48;
            float* dst;
            if (j < 32) dst = t64 + ((size_t)pos * 32 + j) * 2; else dst = t32 + ((size_t)pos * 16 + (j - 32)) * 2;
            const float inv = ROPE_INV[j];
            float s, c; sincos_acc((float)pos * inv, s, c);
            dst[0] = c; dst[1] = s;
        }
    }
}

__device__ __forceinline__ void final_phase(const Frame& F0, const ArgView& A) {
    FRAME_TID(F0);
    const GAS f32x4* g4 = (const GAS f32x4*)A.in(I_FINAL) + F.lane;
    f32x4 g[4];
#pragma unroll
    for (int j = 0; j < 4; ++j) g[j] = g4[64 * j];
    const bf16* hb = WSP(bf16, WS_HBA); float* out = A.out();
    const int rpw = M / F.G;
    for (int m = F.vcu * rpw + F.wave; m < (F.vcu + 1) * rpw; m += NWAVES) {
        const GAS u32x2v* hr = (const GAS u32x2v*)(hb + (size_t)m * DMODEL) + F.lane;
        f32x4 v[4]; float s = 0.f;
#pragma unroll
        for (int j = 0; j < 4; ++j) { const u32x2v w = hr[64 * j]; v[j] = (f32x4){bflo(w.x), bfhi(w.x), bflo(w.y), bfhi(w.y)}; s += (v[j].x * v[j].x + v[j].y * v[j].y) + (v[j].z * v[j].z + v[j].w * v[j].w); }
        const float rs = 1.0f / sqrtf(wave_sum(s) * (1.0f / DMODEL) + NORM_EPS);
        GAS f32x4* xr = (GAS f32x4*)(out + (size_t)m * DMODEL) + F.lane;
#pragma unroll
        for (int j = 0; j < 4; ++j) xr[64 * j] = v[j] * rs * g[j];
    }
}

__device__ __forceinline__ f32x4 ldbf4(const bf16* p) { const u32x2v w = *(const GAS u32x2v*)p; return (f32x4){bflo(w.x), bfhi(w.x), bflo(w.y), bfhi(w.y)}; }
__device__ __forceinline__ f32x2v ldbf2(const bf16* p) { const unsigned w = *(const GAS unsigned*)p; return (f32x2v){bflo(w), bfhi(w)}; }
__device__ __forceinline__ void stbf4(bf16* p, const f32x4& o) { u32x2v w; w.x = cvt_pk_bf16(o[0], o[1]); w.y = cvt_pk_bf16(o[2], o[3]); *(GAS u32x2v*)p = w; }
__device__ __forceinline__ float dot4(const f32x4& a, const f32x4& b) { return (a[0] * b[0] + a[1] * b[1]) + (a[2] * b[2] + a[3] * b[3]); }
__device__ __forceinline__ void fixup_phase(const Frame& F0, const ArgView& A, int l) {
    FRAME_TID(F0);
    const float* halo = WSP(float, WS_HALO); bf16* act = WSP(bf16, WS_ACT);
    const float* cw = A.in(I_CONV_W) + (size_t)l * 3 * NUP; const float* cb = A.in(I_CONV_B) + (size_t)l * NUP;
    constexpr int NG4 = DFF / 4, NITEM = 64 * 2 * NG4;
    const f32x4 zero = (f32x4){0.f, 0.f, 0.f, 0.f};
    const int gsz = F.G / 8, bb = F.vcu / gsz, rk = F.vcu - bb * gsz;
    for (int it = bb * (NITEM / 8) + rk * NTHREADS + F.tid; it < (bb + 1) * (NITEM / 8); it += gsz * NTHREADS) {
        const int g4 = it % NG4, rw = it / NG4, pm = rw >> 1, last = rw & 1;
        const int c = 4 * g4, ucol = (c >> 7) * 256 + (c & 127);
        f32x4 u[2][3];
#pragma unroll
        for (int t = 0; t < 2; ++t) {
            const int uc = ucol + t * 128;
            if (!last) {
                u[t][0] = (pm & 7) ? *(const GAS f32x4*)(halo + ((size_t)(pm - 1) * 4 + 3) * NUP + uc) : zero;
                u[t][1] = *(const GAS f32x4*)(halo + ((size_t)pm * 4 + 0) * NUP + uc);
                u[t][2] = *(const GAS f32x4*)(halo + ((size_t)pm * 4 + 1) * NUP + uc);
            } else {
                u[t][0] = *(const GAS f32x4*)(halo + ((size_t)pm * 4 + 2) * NUP + uc);
                u[t][1] = *(const GAS f32x4*)(halo + ((size_t)pm * 4 + 3) * NUP + uc);
                u[t][2] = ((pm & 7) != 7) ? *(const GAS f32x4*)(halo + ((size_t)(pm + 1) * 4 + 0) * NUP + uc) : zero;
            }
        }
        f32x4 r[2];
#pragma unroll
        for (int t = 0; t < 2; ++t) { const int cc = t * DFF + c;
            r[t] = *(const GAS f32x4*)(cb + cc) + u[t][0] * *(const GAS f32x4*)(cw + cc) + u[t][1] * *(const GAS f32x4*)(cw + NUP + cc) + u[t][2] * *(const GAS f32x4*)(cw + 2 * NUP + cc); }
        f32x4 o;
#pragma unroll
        for (int e = 0; e < 4; ++e) { const float x = r[0][e]; const float z = x + 0.044715f * x * x * x;
            o[e] = x * fast_rcp(1.0f + fast_exp2(-2.0f * LOG2E * 0.7978845608028654f * z)) * r[1][e]; }
        stbf4(act + (size_t)(pm * 256 + (last ? 255 : 0)) * DFF + c, o);
    }
}

#define OSM_STEP(m, lsum, o, s, v) do { const float mn_ = fmaxf(m, s), f_ = fast_exp2(m - mn_), e_ = fast_exp2(s - mn_); o = o * f_ + v * e_; lsum = lsum * f_ + e_; m = mn_; } while (0)

__device__ __forceinline__ void naive_attn_phase(const Frame& F0, const ArgView& A, int l) {
    FRAME_TID(F0);
    bf16* QO = WSP(bf16, X_QO);
    const bf16 *KA = WSP(bf16, X_KA), *VA = WSP(bf16, X_VA), *KC = WSP(bf16, X_KC), *VC = WSP(bf16, X_VC), *KD = WSP(bf16, X_KD), *VD = WSP(bf16, X_VD);
    const bf16 *QB = WSP(bf16, X_QB), *KB = WSP(bf16, X_KB), *VB = WSP(bf16, X_VB);
    const int l16 = F.tid & 15, grp = F.tid >> 4;
    const float lam_init = 0.8f - 0.6f * expf(-0.3f * (float)l);
    float lam;
    { const float* lq1 = A.in(I_LQ1) + l * 32; const float* lk1 = A.in(I_LK1) + l * 32; const float* lq2 = A.in(I_LQ2) + l * 32; const float* lk2 = A.in(I_LK2) + l * 32;
      const float a = g16_sum(lq1[l16] * lk1[l16] + lq1[l16 + 16] * lk1[l16 + 16]), b = g16_sum(lq2[l16] * lk2[l16] + lq2[l16 + 16] * lk2[l16 + 16]);
      lam = expf(a) - expf(b) + lam_init; }
    const float* rpb = A.in(I_RPB) + (size_t)l * 4 * 15 * 31; const float* subln = A.in(I_SUBLN) + l * 64;
    const int NG = 4 * 4 * M;
    for (int g0 = F.vcu * 32; g0 < NG; g0 += F.G * 32) {
        const int g = g0 + grp, mixer = g / (4 * M), rem = g % (4 * M), h = rem / M, r = rem % M;
        const int pos = r & (SEQ - 1), base = r - pos;
        const f32x4 zero = (f32x4){0.f, 0.f, 0.f, 0.f};
        if (mixer == 0) {
            const f32x4 q = ldbf4(QO + (size_t)r * 1024 + h * 64 + l16 * 4);
            f32x4 acc = zero; float wsum = 0.f, gm = -1e30f;
            f32x4 op[3]; float lse[3];
#pragma unroll
            for (int p = 0; p < 3; ++p) {
                const int dil = (p == 0) ? 1 : (p == 1 ? 4 : 16), L = SEQ / dil, nq = pos / dil, rho = pos % dil;
                float m = -1e30f, ls = 0.f; f32x4 o = zero;
                for (int dl = -64; dl <= 64; ++dl) {
                    const int nk = nq + dl;
                    if (nk < 0 || nk >= L) continue;
                    const size_t kr = (size_t)(base + nk * dil + rho);
                    const float s = g16_sum(dot4(q, ldbf4(KA + kr * 256 + h * 64 + l16 * 4)));
                    const f32x4 v = ldbf4(VA + kr * 256 + h * 64 + l16 * 4);
                    OSM_STEP(m, ls, o, s, v);
                }
                op[p] = o * (1.0f / ls); lse[p] = m + __log2f(ls);
            }
            gm = fmaxf(lse[0], fmaxf(lse[1], lse[2]));
#pragma unroll
            for (int p = 0; p < 3; ++p) { const float w = fast_exp2(lse[p] - gm); acc = acc + op[p] * w; wsum += w; }
            stbf4(QO + (size_t)r * 1024 + h * 64 + l16 * 4, acc * (1.0f / wsum));
        } else if (mixer == 1) {
            const bf16* qp = QB + (size_t)r * 384 + h * 96 + l16 * 6;
            const f32x2v q0 = ldbf2(qp), q1 = ldbf2(qp + 2), q2 = ldbf2(qp + 4);
            float m = -1e30f, ls = 0.f; f32x4 o = zero;
            for (int j = 0; j < SEQ; ++j) {
                const bf16* kp = KB + (size_t)(base + j) * 384 + h * 96 + l16 * 6;
                const f32x2v k0 = ldbf2(kp), k1 = ldbf2(kp + 2), k2 = ldbf2(kp + 4);
                const float s = g16_sum((q0.x * k0.x + q0.y * k0.y) + (q1.x * k1.x + q1.y * k1.y) + (q2.x * k2.x + q2.y * k2.y));
                const f32x4 v = ldbf4(VB + (size_t)(base + j) * 256 + h * 64 + l16 * 4);
                OSM_STEP(m, ls, o, s, v);
            }
            stbf4(QO + (size_t)r * 1024 + 256 + h * 64 + l16 * 4, o * (1.0f / ls));
        } else if (mixer == 2) {
            const bf16* qp = QO + (size_t)r * 1024 + 512 + h * 64;
            const f32x2v q1 = ldbf2(qp + l16 * 2), q2 = ldbf2(qp + 32 + l16 * 2);
            float m1 = -1e30f, l1 = 0.f, m2 = -1e30f, l2 = 0.f; f32x4 o1 = zero, o2 = zero;
            for (int j = 0; j < SEQ; ++j) {
                const bf16* kp = KC + (size_t)(base + j) * 256 + h * 64;
                const f32x2v k1 = ldbf2(kp + l16 * 2), k2 = ldbf2(kp + 32 + l16 * 2);
                const float s1 = g16_sum(q1.x * k1.x + q1.y * k1.y), s2 = g16_sum(q2.x * k2.x + q2.y * k2.y);
                const f32x4 v = ldbf4(VC + (size_t)(base + j) * 256 + h * 64 + l16 * 4);
                OSM_STEP(m1, l1, o1, s1, v); OSM_STEP(m2, l2, o2, s2, v);
            }
            f32x4 o = o1 * (1.0f / l1) - o2 * (lam / l2);
            const float ss = g16_sum(dot4(o, o));
            const float rs = (1.0f - lam_init) / sqrtf(ss * (1.0f / 64.0f) + 1e-5f);
            const f32x4 gsub = *(const GAS f32x4*)(subln + l16 * 4);
            stbf4(QO + (size_t)r * 1024 + 512 + h * 64 + l16 * 4, o * gsub * rs);
        } else {
            const int gr = pos >> 6, gc = pos & 63;
            int rs_ = gr - 4; rs_ = rs_ < 0 ? 0 : (rs_ > 24 ? 24 : rs_);
            int cs_ = gc - 8; cs_ = cs_ < 0 ? 0 : (cs_ > 48 ? 48 : cs_);
            const f32x4 q = ldbf4(QO + (size_t)r * 1024 + 768 + h * 64 + l16 * 4);
            float m = -1e30f, ls = 0.f; f32x4 o = zero;
            for (int jr = 0; jr < 8; ++jr)
                for (int jc = 0; jc < 16; ++jc) {
                    const int kr_ = rs_ + jr, kc = cs_ + jc; const size_t krow = (size_t)(base + kr_ * 64 + kc);
                    const float s = g16_sum(dot4(q, ldbf4(KD + krow * 256 + h * 64 + l16 * 4))) + LOG2E * rpb[(h * 15 + (kr_ - gr + 7)) * 31 + (kc - gc + 15)];
                    const f32x4 v = ldbf4(VD + krow * 256 + h * 64 + l16 * 4);
                    OSM_STEP(m, ls, o, s, v);
                }
            stbf4(QO + (size_t)r * 1024 + 768 + h * 64 + l16 * 4, o * (1.0f / ls));
        }
    }
}

namespace att {
typedef short bf16x8 __attribute__((ext_vector_type(8)));
typedef short s16x4 __attribute__((ext_vector_type(4)));
typedef short v4i16_t __attribute__((ext_vector_type(4)));
typedef __attribute__((address_space(3))) const unsigned char* lds_cptr;
constexpr int K_SLOT = 12288, V_SLOT = 8192, NKS = 4, NVS = 3, LDS_K = 0, LDS_V = NKS * K_SLOT, LDS_RPB = LDS_V + NVS * V_SLOT, LDS_ATT_END = LDS_RPB + 2048;
constexpr float NEGB = -1e30f, FLOORM = -1e4f;
__device__ __forceinline__ int crow(int r, int hi) { return (r & 3) + 8 * (r >> 2) + 4 * hi; }
__device__ __forceinline__ s16x4 vtr(lds_cptr p) { return __builtin_bit_cast(s16x4, __builtin_amdgcn_ds_read_tr16_b64_v4i16((__attribute__((address_space(3))) v4i16_t*)p)); }
__device__ __forceinline__ float xhalf_max(float m) { auto rr = __builtin_amdgcn_permlane32_swap(__float_as_uint(m), __float_as_uint(m), false, false); return fmaxf(__uint_as_float(rr[0]), __uint_as_float(rr[1])); }
__device__ __forceinline__ float xhalf_sum(float m) { auto rr = __builtin_amdgcn_permlane32_swap(__float_as_uint(m), __float_as_uint(m), false, false); return __uint_as_float(rr[0]) + __uint_as_float(rr[1]); }

constexpr float THR = 8.0f;
struct SM { float mref, l; f32x16 negm; };

#define MX3(a, b, c) __builtin_fmaxf(__builtin_fmaxf((a), (b)), (c))
__device__ __forceinline__ float rowmax32(const f32x16& p0, const f32x16& p1) {
    float a = MX3(p0[0], p0[1], p1[0]), b = MX3(p0[2], p0[3], p1[1]); a = MX3(a, p1[2], p1[3]);
#pragma unroll
    for (int r = 4; r < 16; r += 4) { a = MX3(a, p0[r], p0[r + 1]); b = MX3(b, p0[r + 2], p0[r + 3]); a = MX3(a, p1[r], p1[r + 1]); b = MX3(b, p1[r + 2], p1[r + 3]); }
    return xhalf_max(__builtin_fmaxf(a, b));
}
__device__ __forceinline__ unsigned pk(float lo, float hi) { return cvt_pk_bf16(lo, hi); }
__device__ __forceinline__ bf16x8 packp(const f32x16& p, int b) {
    v4u w; w.x = pk(p[b], p[b + 1]); w.y = pk(p[b + 2], p[b + 3]); w.z = pk(p[b + 4], p[b + 5]); w.w = pk(p[b + 6], p[b + 7]); return __builtin_bit_cast(bf16x8, w);
}
__device__ __forceinline__ void scale_o(f32x16 (&o)[2], float a) {
#pragma unroll
    for (int d0 = 0; d0 < 2; ++d0)
#pragma unroll
        for (int r = 0; r < 16; ++r) o[d0][r] *= a;
}
template <bool ADJ_NEXT>
__device__ __forceinline__ void smx_tile(f32x16& p0, f32x16& p1, SM& s, f32x16 (&o)[2], bool fresh, f32x16& n0, f32x16& n1, bool have_next) {
    const float rm = rowmax32(p0, p1);
    if (fresh || __any(rm > THR)) {
        const float dl = fresh ? __builtin_fmaxf(rm, FLOORM) : __builtin_fmaxf(rm, 0.f);
        s.mref += dl;
#pragma unroll
        for (int r = 0; r < 16; ++r) { p0[r] -= dl; p1[r] -= dl; }
        if (ADJ_NEXT && have_next) {
#pragma unroll
            for (int r = 0; r < 16; ++r) { n0[r] -= dl; n1[r] -= dl; }
        }
#pragma unroll
        for (int r = 0; r < 16; ++r) s.negm[r] = -s.mref;
        if (!fresh) { const float al = fast_exp2(-dl); s.l *= al; scale_o(o, al); }
    }
    float sum = 0.f;
#pragma unroll
    for (int r = 0; r < 16; ++r) { p0[r] = fast_exp2(p0[r]); p1[r] = fast_exp2(p1[r]); sum += p0[r] + p1[r]; }
    s.l += sum;
}
__device__ __forceinline__ void pv_tile(f32x16 (&o)[2], lds_cptr vp, const f32x16& p0, const f32x16& p1) {
    const bf16x8 pa0 = packp(p0, 0), pa1 = packp(p0, 8), pa2 = packp(p1, 0), pa3 = packp(p1, 8);
#pragma unroll
    for (int d0 = 0; d0 < 2; ++d0) {
        s16x4 lo[4], hi[4];
#pragma unroll
        for (int ks = 0; ks < 4; ++ks) { lo[ks] = vtr(vp + d0 * 4096 + ks * 1024); hi[ks] = vtr(vp + d0 * 4096 + ks * 1024 + 512); }
        __builtin_amdgcn_sched_barrier(0);
#pragma unroll
        for (int ks = 0; ks < 4; ++ks) {
            const bf16x8 vf = (bf16x8){lo[ks][0], lo[ks][1], lo[ks][2], lo[ks][3], hi[ks][0], hi[ks][1], hi[ks][2], hi[ks][3]};
            o[d0] = __builtin_amdgcn_mfma_f32_32x32x16_bf16(vf, ks == 0 ? pa0 : ks == 1 ? pa1 : ks == 2 ? pa2 : pa3, o[d0], 0, 0, 0);
        }
    }
}
struct VH { s16x4 lo[4], hi[4]; };
__device__ __forceinline__ void pv_reads(VH& f, lds_cptr vp, int d0) {
#pragma unroll
    for (int ks = 0; ks < 4; ++ks) { f.lo[ks] = vtr(vp + d0 * 4096 + ks * 1024); f.hi[ks] = vtr(vp + d0 * 4096 + ks * 1024 + 512); }
}
__device__ __forceinline__ void pv_mfmas(f32x16& o, const VH& f, const bf16x8& pa0, const bf16x8& pa1, const bf16x8& pa2, const bf16x8& pa3) {
#pragma unroll
    for (int ks = 0; ks < 4; ++ks) {
        const bf16x8 vf = (bf16x8){f.lo[ks][0], f.lo[ks][1], f.lo[ks][2], f.lo[ks][3], f.hi[ks][0], f.hi[ks][1], f.hi[ks][2], f.hi[ks][3]};
        o = __builtin_amdgcn_mfma_f32_32x32x16_bf16(vf, ks == 0 ? pa0 : ks == 1 ? pa1 : ks == 2 ? pa2 : pa3, o, 0, 0, 0);
    }
}
__device__ __forceinline__ void store_o(bf16* orow, const f32x16 (&o)[2], float sc, int hi) {
#pragma unroll
    for (int d0 = 0; d0 < 2; ++d0)
#pragma unroll
        for (int gp = 0; gp < 2; ++gp) {
            const int ge = 2 * gp, go = ge + 1;
            const unsigned e0 = pk(o[d0][4 * ge] * sc, o[d0][4 * ge + 1] * sc), e1 = pk(o[d0][4 * ge + 2] * sc, o[d0][4 * ge + 3] * sc);
            const unsigned o0 = pk(o[d0][4 * go] * sc, o[d0][4 * go + 1] * sc), o1 = pk(o[d0][4 * go + 2] * sc, o[d0][4 * go + 3] * sc);
            auto s0 = __builtin_amdgcn_permlane32_swap(e0, o0, false, false); auto s1 = __builtin_amdgcn_permlane32_swap(e1, o1, false, false);
            v4u w; w.x = s0[0]; w.y = s1[0]; w.z = s0[1]; w.w = s1[1];
            *(GAS v4u*)(orow + 32 * d0 + 8 * (ge + hi)) = w; }
}

__device__ __forceinline__ void glds16(const void* gsrc, unsigned lds_dst) { unsigned keep;
    asm volatile("s_mov_b32 %0, m0\n\ts_mov_b32 m0, %2\n\ts_nop 0\n\tglobal_load_lds_dwordx4 %1, off\n\ts_mov_b32 m0, %0" : "=&s"(keep) : "v"(gsrc), "s"(lds_dst) : "memory"); }
template <int NCH> __device__ __forceinline__ void k_dma(const bf16* K, int kpitch, int krow_lane, unsigned lds0, int slot, int wave) {
#pragma unroll
    for (int i = 0; i < (NCH + 7) / 8; ++i) { const int c = wave + 8 * i; if (c < NCH) glds16(K + (size_t)krow_lane * kpitch + 8 * c, (unsigned)__builtin_amdgcn_readfirstlane(lds0 + LDS_K + slot * K_SLOT + c * 1024)); }
}
__device__ __forceinline__ void v_dma(const bf16* V, int vpitch, int vrow_lane, unsigned lds0, int slot, int wave, int lane) {
    glds16(V + (size_t)vrow_lane * vpitch + (wave >> 2) * 32 + (lane & 3) * 8, (unsigned)__builtin_amdgcn_readfirstlane(lds0 + LDS_V + slot * V_SLOT + wave * 1024));
}
__device__ __forceinline__ void wait_bar(int n) {
    switch (n) {
        case 0: asm volatile("s_waitcnt vmcnt(0)" ::: "memory"); break;
        case 1: asm volatile("s_waitcnt vmcnt(1)" ::: "memory"); break;
        case 2: asm volatile("s_waitcnt vmcnt(2)" ::: "memory"); break;
        case 3: asm volatile("s_waitcnt vmcnt(3)" ::: "memory"); break;
        case 4: asm volatile("s_waitcnt vmcnt(4)" ::: "memory"); break;
        default: asm volatile("s_waitcnt vmcnt(5)" ::: "memory"); break;
    }
    asm volatile("s_waitcnt lgkmcnt(0)" ::: "memory"); __builtin_amdgcn_s_barrier(); asm volatile("" ::: "memory");
}

template <int ND0> __device__ __forceinline__ void qk_tile(f32x16& p0, f32x16& p1, lds_cptr kb, const bf16x8* qr, const f32x16& negm) {
    constexpr int NB = (ND0 + 2) / 3, BS = (ND0 + NB - 1) / NB;
#pragma unroll
    for (int bt = 0; bt < NB; ++bt) {
        bf16x8 k0[BS], k1[BS];
#pragma unroll
        for (int i = 0; i < BS; ++i) { const int d0 = bt * BS + i; if (d0 < ND0) { k0[i] = *(const __attribute__((address_space(3))) bf16x8*)(kb + d0 * 2048); k1[i] = *(const __attribute__((address_space(3))) bf16x8*)(kb + d0 * 2048 + 512); } }
        __builtin_amdgcn_sched_barrier(0);
#pragma unroll
        for (int i = 0; i < BS; ++i) { const int d0 = bt * BS + i; if (d0 < ND0) {
            if (d0 == 0) { p0 = __builtin_amdgcn_mfma_f32_32x32x16_bf16(k0[i], qr[0], negm, 0, 0, 0); p1 = __builtin_amdgcn_mfma_f32_32x32x16_bf16(k1[i], qr[0], negm, 0, 0, 0); }
            else { p0 = __builtin_amdgcn_mfma_f32_32x32x16_bf16(k0[i], qr[d0], p0, 0, 0, 0); p1 = __builtin_amdgcn_mfma_f32_32x32x16_bf16(k1[i], qr[d0], p1, 0, 0, 0); } } }
    }
}

template <int ND0, class Pol>
__device__ __forceinline__ void attn_unit(const Pol& P, LAS unsigned char* lds, const bf16* Q, int qpitch, const bf16* K, int kpitch, const bf16* V, int vpitch,
                                          f32x16 (&o)[2], SM& st, int wave, int lane) {
    constexpr int NCH = 2 * ND0;
    const int r32 = lane & 31, hi = lane >> 5;
    const unsigned lds0 = (unsigned)(unsigned long)lds;
    const int nk = (wave < NCH ? 1 : 0) + (wave + 8 < NCH ? 1 : 0);
    const int nt = P.ntiles();
    const int vj = 16 * (wave & 3) + (lane >> 2);
    k_dma<NCH>(K, kpitch, P.key_row(0, lane), lds0, 0, wave); v_dma(V, vpitch, P.key_row(0, vj), lds0, 0, wave, lane);
    if (nt > 1) k_dma<NCH>(K, kpitch, P.key_row(1, lane), lds0, 1, wave);
    if (nt > 1) v_dma(V, vpitch, P.key_row(1, vj), lds0, 1, wave, lane);
    if (nt > 2) k_dma<NCH>(K, kpitch, P.key_row(2, lane), lds0, 2, wave);
    bf16x8 qr[ND0];
    { const bf16* qp = Q + (size_t)P.q_row(wave, r32) * qpitch;
#pragma unroll
      for (int d0 = 0; d0 < ND0; ++d0) qr[d0] = *(const GAS bf16x8*)(qp + d0 * 16 + hi * 8); }
    st.mref = 0.f; st.l = 0.f; st.negm = f32x16{}; o[0] = f32x16{}; o[1] = f32x16{};
#pragma unroll
    for (int d0 = 0; d0 < ND0; ++d0) asm volatile("" : "+v"(qr[d0]));
    wait_bar((nt > 1 ? 1 : 0) + (nt > 2 ? nk : 0));
    const lds_cptr l3 = (lds_cptr)lds;
    const lds_cptr kp0 = l3 + LDS_K + hi * 1024 + r32 * 16;
    const lds_cptr vp0 = l3 + LDS_V + ((lane >> 4) & 1) * 32 + (lane & 3) * 8 + (4 * hi + ((lane & 15) >> 2)) * 64;
    f32x16 a0, a1, b0, b1;
    a0 = f32x16{}; a1 = f32x16{}; b0 = f32x16{}; b1 = f32x16{};
    bool fresh = true;
    if (!P.skip(0, wave)) qk_tile<ND0>(a0, a1, kp0, qr, st.negm);
    int vs_cur = 0, vs_wr = 2;
#define ATT_ITER1(TT, C0, C1, N0, N1) do { const int ti_ = (TT); \
        const bool ik_ = ti_ + 3 < nt, iv_ = ti_ + 2 < nt; \
        if (ik_) k_dma<NCH>(K, kpitch, P.key_row(ti_ + 3, lane), lds0, (ti_ + 3) & 3, wave); \
        if (iv_) v_dma(V, vpitch, P.key_row(ti_ + 2, vj), lds0, vs_wr, wave, lane); \
        const bool dn_ = (ti_ + 1 < nt) && !P.skip(ti_ + 1, wave), dc_ = !P.skip(ti_, wave); \
        VH v0_, v1_; if (dc_) { pv_reads(v0_, vp0 + vs_cur * V_SLOT, 0); __builtin_amdgcn_sched_barrier(0); }     \
        if (dn_) qk_tile<ND0>(N0, N1, kp0 + ((ti_ + 1) & 3) * K_SLOT, qr, st.negm); \
        if (dc_) { P.mask(C0, C1, ti_, wave, r32, hi); smx_tile<true>(C0, C1, st, o, fresh, N0, N1, dn_); fresh = false; \
            const bf16x8 pa0_ = packp(C0, 0), pa1_ = packp(C0, 8), pa2_ = packp(C1, 0), pa3_ = packp(C1, 8); \
            pv_reads(v1_, vp0 + vs_cur * V_SLOT, 1); __builtin_amdgcn_sched_barrier(0); pv_mfmas(o[0], v0_, pa0_, pa1_, pa2_, pa3_); pv_mfmas(o[1], v1_, pa0_, pa1_, pa2_, pa3_); } \
        wait_bar((ik_ ? nk : 0) + (iv_ ? 1 : 0)); \
        vs_cur = (vs_cur == NVS - 1) ? 0 : vs_cur + 1; vs_wr = (vs_wr == NVS - 1) ? 0 : vs_wr + 1; } while (0)
    for (int t = 0; t < nt; t += 2) {
        ATT_ITER1(t, a0, a1, b0, b1);
        if (t + 1 < nt) ATT_ITER1(t + 1, b0, b1, a0, a1);
    }
#undef ATT_ITER1
}

template <class Pol>
__device__ __forceinline__ void attn_unit_c(const Pol& P, LAS unsigned char* lds, const bf16* Q, int qpitch, const bf16* K, int kpitch, const bf16* V, int vpitch,
                                            f32x16 (&o)[2][2], SM (&st)[2], int wave, int lane) {
    constexpr int NCH = 8, NR = 3;
    const int r32 = lane & 31, hi = lane >> 5;
    const unsigned lds0 = (unsigned)(unsigned long)lds;
    const int nt = P.ntiles();
    const int vj = 16 * (wave & 3) + (lane >> 2);
    k_dma<NCH>(K, kpitch, P.key_row(0, lane), lds0, 0, wave); v_dma(V, vpitch, P.key_row(0, vj), lds0, 0, wave, lane);
    if (nt > 1) { k_dma<NCH>(K, kpitch, P.key_row(1, lane), lds0, 1, wave); v_dma(V, vpitch, P.key_row(1, vj), lds0, 1, wave, lane); }
    bf16x8 qr[2][2];
    { const bf16* qp = Q + (size_t)P.q_row(wave, r32) * qpitch;
#pragma unroll
      for (int mp = 0; mp < 2; ++mp)
#pragma unroll
          for (int d0 = 0; d0 < 2; ++d0) qr[mp][d0] = *(const GAS bf16x8*)(qp + mp * 32 + d0 * 16 + hi * 8); }
#pragma unroll
    for (int mp = 0; mp < 2; ++mp) { st[mp].mref = 0.f; st[mp].l = 0.f; st[mp].negm = f32x16{}; o[mp][0] = f32x16{}; o[mp][1] = f32x16{}; }
#pragma unroll
    for (int mp = 0; mp < 2; ++mp)
#pragma unroll
        for (int d0 = 0; d0 < 2; ++d0) asm volatile("" : "+v"(qr[mp][d0]));
    wait_bar(nt > 1 ? 2 : 0);
    const lds_cptr l3 = (lds_cptr)lds;
    const lds_cptr kp0 = l3 + LDS_K + hi * 1024 + r32 * 16;
    const lds_cptr vp0 = l3 + LDS_V + ((lane >> 4) & 1) * 32 + (lane & 3) * 8 + (4 * hi + ((lane & 15) >> 2)) * 64;
    bool fresh = true;
    int sc = 0, sw = 2;
    for (int t = 0; t < nt; ++t) {
        const bool is2 = t + 2 < nt;
        if (is2) { k_dma<NCH>(K, kpitch, P.key_row(t + 2, lane), lds0, sw, wave); v_dma(V, vpitch, P.key_row(t + 2, vj), lds0, sw, wave, lane); }
        VH v0_, v1_; pv_reads(v0_, vp0 + sc * V_SLOT, 0); __builtin_amdgcn_sched_barrier(0);
#pragma unroll
        for (int mp = 0; mp < 2; ++mp) {
            f32x16 p0, p1;
            qk_tile<2>(p0, p1, kp0 + sc * K_SLOT + mp * 4096, qr[mp], st[mp].negm);
            if (mp == 0) { pv_reads(v1_, vp0 + sc * V_SLOT, 1); __builtin_amdgcn_sched_barrier(0); }
            smx_tile<false>(p0, p1, st[mp], o[mp], fresh, p0, p1, false);
            const bf16x8 pa0_ = packp(p0, 0), pa1_ = packp(p0, 8), pa2_ = packp(p1, 0), pa3_ = packp(p1, 8);
            pv_mfmas(o[mp][0], v0_, pa0_, pa1_, pa2_, pa3_); pv_mfmas(o[mp][1], v1_, pa0_, pa1_, pa2_, pa3_);
        }
        fresh = false;
        wait_bar(is2 ? 2 : 0);
        sc = (sc == NR - 1) ? 0 : sc + 1; sw = (sw == NR - 1) ? 0 : sw + 1;
    }
}

struct PolDense {
    int base, q0;
    __device__ __forceinline__ int ntiles() const { return SEQ / 64; }
    __device__ __forceinline__ int key_row(int t, int j) const { return base + 64 * t + j; }
    __device__ __forceinline__ bool skip(int, int) const { return false; }
    __device__ __forceinline__ void mask(f32x16&, f32x16&, int, int, int, int) const {}
    __device__ __forceinline__ int q_row(int wave, int r32) const { return q0 + 32 * wave + r32; }
};
struct PolBand {
    int gbase0, gstep, dil, L, nk0, tpg, nt, nq0w, wgrp;
    __device__ __forceinline__ int ntiles() const { return nt; }
    __device__ __forceinline__ int key_row(int t, int j) const { const int g = t / tpg; int nk = nk0 + 64 * (t - g * tpg) + j; nk = nk < 0 ? 0 : (nk > L - 1 ? L - 1 : nk); return gbase0 + g * gstep + nk * dil; }
    __device__ __forceinline__ bool skip(int t, int) const { const int g = t / tpg, k0 = nk0 + 64 * (t - g * tpg); return g != wgrp || k0 + 63 < nq0w - 64 || k0 > nq0w + 31 + 64 || k0 + 63 < 0 || k0 >= L; }
    __device__ __forceinline__ void mask(f32x16& p0, f32x16& p1, int t, int, int r32, int hi) const {
        const int g = t / tpg, k0 = nk0 + 64 * (t - g * tpg), nq = nq0w + r32;
#pragma unroll
        for (int r = 0; r < 16; ++r) { const int nk = k0 + crow(r, hi), d0 = nk - nq, nk1 = nk + 32, d1 = nk1 - nq;
            if (!((unsigned)nk < (unsigned)L && d0 >= -64 && d0 <= 64)) p0[r] = NEGB;
            if (!((unsigned)nk1 < (unsigned)L && d1 >= -64 && d1 <= 64)) p1[r] = NEGB; }
    }
    __device__ __forceinline__ int q_row(int, int r32) const { return gbase0 + wgrp * gstep + (nq0w + r32) * dil; }
};
struct PolNA {
    int base, kr0, nt, R, cb; const LAS float* rpb;
    __device__ __forceinline__ int ntiles() const { return nt; }
    __device__ __forceinline__ int key_row(int t, int j) const { return base + (kr0 + t) * 64 + j; }
    __device__ __forceinline__ int kstart() const { const int s = R - 4; return s < 0 ? 0 : (s > 24 ? 24 : s); }
    __device__ __forceinline__ bool skip(int t, int) const { const int kr = kr0 + t, ks = kstart(); return kr < ks || kr >= ks + 8; }
    __device__ __forceinline__ void mask(f32x16& p0, f32x16& p1, int t, int, int r32, int hi) const {
        const int qc = cb + r32; int cs = qc - 8; cs = cs < 0 ? 0 : (cs > 48 ? 48 : cs);
        const LAS float* row = rpb + (kr0 + t - R + 7) * 31 + 15 - qc;
#pragma unroll
        for (int g = 0; g < 4; ++g) {
#pragma unroll
            for (int e = 0; e < 4; ++e) { const int r = 4 * g + e, kc = crow(r, hi), kc1 = kc + 32;
                const bool ok0 = (unsigned)(kc - cs) < 16u, ok1 = (unsigned)(kc1 - cs) < 16u;
                const float b0 = row[kc], b1 = row[kc1];
                p0[r] = ok0 ? p0[r] + b0 : NEGB; p1[r] = ok1 ? p1[r] + b1 : NEGB; }
            asm volatile("" ::: "memory");
        }
    }
    __device__ __forceinline__ int q_row(int, int r32) const { return base + R * 64 + cb + r32; }
};

template <class Pol>
__device__ __forceinline__ void attn_wave_unit(const Pol& P, LAS unsigned char* wlds, const bf16* Q, int qpitch, const bf16* K, int kpitch, const bf16* V, int vpitch,
                                               f32x16 (&o)[2], SM& st, int lane) {
    const int r32 = lane & 31, hi = lane >> 5;
    const unsigned lds0 = (unsigned)(unsigned long)wlds;
    bf16x8 qr[4];
    { const bf16* qp = Q + (size_t)P.q_row(r32) * qpitch;
#pragma unroll
      for (int d0 = 0; d0 < 4; ++d0) qr[d0] = *(const GAS bf16x8*)(qp + d0 * 16 + hi * 8); }
    st.mref = 0.f; st.l = 0.f; st.negm = f32x16{}; o[0] = f32x16{}; o[1] = f32x16{};
#pragma unroll
    for (int d0 = 0; d0 < 4; ++d0) asm volatile("" : "+v"(qr[d0]));
    const lds_cptr kp0 = (lds_cptr)wlds + r32 * 128;
    const lds_cptr vp0 = (lds_cptr)wlds + 8192 + ((lane >> 4) & 1) * 32 + (lane & 3) * 8 + (4 * hi + ((lane & 15) >> 2)) * 64;
    const int krow = lane >> 3, kslot = lane & 7;
    bool fresh = true;
    const int nt = P.ntiles();
    for (int tt = 0; tt < nt; ++tt) {
        if (P.skip(tt)) continue;
        asm volatile("s_waitcnt lgkmcnt(0)" ::: "memory");
#pragma unroll
        for (int i = 0; i < 8; ++i) { const int row = 8 * i + krow;
            glds16(K + (size_t)P.key_row(tt, row) * kpitch + ((kslot ^ (row & 7)) * 8), (unsigned)__builtin_amdgcn_readfirstlane(lds0 + i * 1024)); }
#pragma unroll
        for (int p = 0; p < 8; ++p) glds16(V + (size_t)P.key_row(tt, 16 * (p & 3) + (lane >> 2)) * vpitch + (p >> 2) * 32 + (lane & 3) * 8, (unsigned)__builtin_amdgcn_readfirstlane(lds0 + 8192 + p * 1024));
        asm volatile("s_waitcnt vmcnt(8)" ::: "memory");
        f32x16 p0, p1;
#pragma unroll
        for (int d0 = 0; d0 < 4; ++d0) {
            const int sw = ((2 * d0 + hi) ^ (r32 & 7)) * 16;
            const bf16x8 k0 = *(const __attribute__((address_space(3))) bf16x8*)(kp0 + sw), k1 = *(const __attribute__((address_space(3))) bf16x8*)(kp0 + 4096 + sw);
            if (d0 == 0) { p0 = __builtin_amdgcn_mfma_f32_32x32x16_bf16(k0, qr[0], st.negm, 0, 0, 0); p1 = __builtin_amdgcn_mfma_f32_32x32x16_bf16(k1, qr[0], st.negm, 0, 0, 0); }
            else { p0 = __builtin_amdgcn_mfma_f32_32x32x16_bf16(k0, qr[d0], p0, 0, 0, 0); p1 = __builtin_amdgcn_mfma_f32_32x32x16_bf16(k1, qr[d0], p1, 0, 0, 0); }
        }
        P.mask(p0, p1, tt, r32, hi);
        smx_tile<false>(p0, p1, st, o, fresh, p0, p1, false); fresh = false;
        asm volatile("s_waitcnt vmcnt(0)" ::: "memory");
        pv_tile(o, vp0, p0, p1);
    }
    asm volatile("s_waitcnt lgkmcnt(0)" ::: "memory");
}
struct PolBandW {
    int gbase, dil, L, nq0;
    __device__ __forceinline__ int ntiles() const { return 3; }
    __device__ __forceinline__ int key_row(int tt, int j) const { int nk = nq0 - 64 + 64 * tt + j; nk = nk < 0 ? 0 : (nk > L - 1 ? L - 1 : nk); return gbase + nk * dil; }
    __device__ __forceinline__ bool skip(int tt) const { const int k0 = nq0 - 64 + 64 * tt; return k0 + 63 < 0 || k0 >= L; }
    __device__ __forceinline__ void mask(f32x16& p0, f32x16& p1, int tt, int r32, int hi) const {
        const int k0 = nq0 - 64 + 64 * tt, dq = 64 - 64 * tt + r32;
        int lo = dq - 64; lo = lo > -k0 ? lo : -k0; int up = dq + 64; up = up < L - 1 - k0 ? up : L - 1 - k0;
        if (__all(lo <= 0 && up >= 63)) return;
        const unsigned span = up >= lo ? (unsigned)(up - lo) : 0u; const int lo2 = (up >= lo ? lo : 4096) - 4 * hi;
#pragma unroll
        for (int r = 0; r < 16; ++r) { const int c = (r & 3) + 8 * (r >> 2);
            if ((unsigned)(c - lo2) > span) p0[r] = NEGB;
            if ((unsigned)(c + 32 - lo2) > span) p1[r] = NEGB; }
    }
    __device__ __forceinline__ int q_row(int r32) const { return gbase + (nq0 + r32) * dil; }
};
struct PolBandR {
    int gbase0, gstep, dil, L, nk0, tpg, ntl, wgrp, nq0, t0, ntw;
    __device__ __forceinline__ int key_row(int t, int j) const { const int g = t / tpg; int nk = nk0 + 64 * (t - g * tpg) + j; nk = nk < 0 ? 0 : (nk > L - 1 ? L - 1 : nk); return gbase0 + g * gstep + nk * dil; }
    __device__ __forceinline__ int tile_k0(int t) const { const int g = t / tpg; return nk0 + 64 * (t - g * tpg); }
    __device__ __forceinline__ int q_row(int r32) const { return gbase0 + wgrp * gstep + (nq0 + r32) * dil; }
};
__device__ __forceinline__ void band_mask(f32x16& p0, f32x16& p1, int k0, int nq0, int L, int r32, int hi) {
    const int dq = nq0 + r32 - k0;
    int lo = dq - 64; lo = lo > -k0 ? lo : -k0; int up = dq + 64; up = up < L - 1 - k0 ? up : L - 1 - k0;
    if (__all(lo <= 0 && up >= 63)) return;
    const unsigned span = up >= lo ? (unsigned)(up - lo) : 0u; const int lo2 = (up >= lo ? lo : 4096) - 4 * hi;
#pragma unroll
    for (int r = 0; r < 16; ++r) { const int c = (r & 3) + 8 * (r >> 2);
        if ((unsigned)(c - lo2) > span) p0[r] = NEGB;
        if ((unsigned)(c + 32 - lo2) > span) p1[r] = NEGB; }
}
__device__ __forceinline__ void attn_resident_unit(const PolBandR& P, LAS unsigned char* lds, const bf16* Q, int qpitch, const bf16* K, int kpitch, const bf16* V, int vpitch,
                                                   f32x16 (&o)[2], SM& st, int wave, int lane) {
    const int r32 = lane & 31, hi = lane >> 5;
    const unsigned lds0 = (unsigned)(unsigned long)lds;
    const int krow = 8 * wave + (lane >> 3), kslot = lane & 7;
    for (int t = 0; t < P.ntl; ++t) {
        glds16(K + (size_t)P.key_row(t, krow) * kpitch + ((kslot ^ (krow & 7)) * 8), (unsigned)__builtin_amdgcn_readfirstlane(lds0 + t * 16384 + wave * 1024));
        glds16(V + (size_t)P.key_row(t, 16 * (wave & 3) + (lane >> 2)) * vpitch + (wave >> 2) * 32 + (lane & 3) * 8, (unsigned)__builtin_amdgcn_readfirstlane(lds0 + t * 16384 + 8192 + wave * 1024));
    }
    bf16x8 qr[4];
    { const bf16* qp = Q + (size_t)P.q_row(r32) * qpitch;
#pragma unroll
      for (int d0 = 0; d0 < 4; ++d0) qr[d0] = *(const GAS bf16x8*)(qp + d0 * 16 + hi * 8); }
    st.mref = 0.f; st.l = 0.f; st.negm = f32x16{}; o[0] = f32x16{}; o[1] = f32x16{};
#pragma unroll
    for (int d0 = 0; d0 < 4; ++d0) asm volatile("" : "+v"(qr[d0]));
    wait_bar(0);
    bool fresh = true;
    for (int i = 0; i < P.ntw; ++i) {
        const int t = P.t0 + i, k0 = P.tile_k0(t);
        if (k0 + 63 < 0 || k0 >= P.L) continue;
        const lds_cptr kp0 = (lds_cptr)lds + t * 16384 + r32 * 128;
        const lds_cptr vp0 = (lds_cptr)lds + t * 16384 + 8192 + ((lane >> 4) & 1) * 32 + (lane & 3) * 8 + (4 * hi + ((lane & 15) >> 2)) * 64;
        f32x16 p0, p1;
        bf16x8 k0f[4], k1f[4];
#pragma unroll
        for (int d0 = 0; d0 < 4; ++d0) { const int sw = ((2 * d0 + hi) ^ (r32 & 7)) * 16;
            k0f[d0] = *(const __attribute__((address_space(3))) bf16x8*)(kp0 + sw); k1f[d0] = *(const __attribute__((address_space(3))) bf16x8*)(kp0 + 4096 + sw); }
        __builtin_amdgcn_sched_barrier(0);
#pragma unroll
        for (int d0 = 0; d0 < 4; ++d0) {
            if (d0 == 0) { p0 = __builtin_amdgcn_mfma_f32_32x32x16_bf16(k0f[0], qr[0], st.negm, 0, 0, 0); p1 = __builtin_amdgcn_mfma_f32_32x32x16_bf16(k1f[0], qr[0], st.negm, 0, 0, 0); }
            else { p0 = __builtin_amdgcn_mfma_f32_32x32x16_bf16(k0f[d0], qr[d0], p0, 0, 0, 0); p1 = __builtin_amdgcn_mfma_f32_32x32x16_bf16(k1f[d0], qr[d0], p1, 0, 0, 0); }
        }
        band_mask(p0, p1, k0, P.nq0, P.L, r32, hi);
        smx_tile<false>(p0, p1, st, o, fresh, p0, p1, false); fresh = false;
        pv_tile(o, vp0, p0, p1);
    }
    wait_bar(0);
}
struct PolNAW {
    int base, R, cb, ks; const LAS float* rpb;
    f32x16 am0, am1;
    __device__ __forceinline__ void init_mask(int r32, int hi) {
        const int qc = cb + r32; int cs = qc - 8; cs = cs < 0 ? 0 : (cs > 48 ? 48 : cs);
#pragma unroll
        for (int r = 0; r < 16; ++r) { const int kc = crow(r, hi); am0[r] = ((unsigned)(kc - cs) < 16u) ? 0.f : NEGB; am1[r] = ((unsigned)(kc + 32 - cs) < 16u) ? 0.f : NEGB; }
    }
    __device__ __forceinline__ int ntiles() const { return 8; }
    __device__ __forceinline__ int key_row(int tt, int j) const { return base + (ks + tt) * 64 + j; }
    __device__ __forceinline__ bool skip(int) const { return false; }
    __device__ __forceinline__ void mask(f32x16& p0, f32x16& p1, int tt, int r32, int hi) const {
        const int qc = cb + r32;
        const LAS float* row = rpb + (ks + tt - R + 7) * 31 + 15 - qc + 4 * hi;
#pragma unroll
        for (int r = 0; r < 16; ++r) { const int c = (r & 3) + 8 * (r >> 2);
            p0[r] = (p0[r] + row[c]) + am0[r]; p1[r] = (p1[r] + row[c + 32]) + am1[r]; }
    }
    __device__ __forceinline__ int q_row(int r32) const { return base + R * 64 + cb + r32; }
};
}

__device__ __forceinline__ void attn_a_phase(const Frame& F0, const ArgView& A, int l) {
    FRAME_TID(F0);
    using namespace att;
    constexpr bool dummy = false;
    const bf16* QO = WSP(bf16, X_QO);
    bf16* OAw = (bf16*)A.out(); float* LSEw = (float*)((unsigned char*)A.out() + 24 * MiB);
    const int wave = F.wave, lane = F.lane, r32 = lane & 31, hi = lane >> 5;
    const int bh = F.vcu >> 3, sub = F.vcu & 7, b = bh >> 2, h = bh & 3, base = b * SEQ;
    LAS unsigned char* lds = F.lds;
    for (int p = 0; p < 3; ++p) {
        PolBandR P;
        if (p == 0) { P.gbase0 = base; P.gstep = 0; P.dil = 1; P.L = SEQ; P.nk0 = 256 * sub - 64; P.tpg = 6; P.ntl = 6; P.wgrp = 0; P.nq0 = 256 * sub + 32 * wave; P.t0 = wave >> 1; P.ntw = 3; }
        else if (p == 1) { P.gbase0 = base + (sub >> 1); P.gstep = 0; P.dil = 4; P.L = SEQ / 4; P.nk0 = 256 * (sub & 1) - 64; P.tpg = 6; P.ntl = 6; P.wgrp = 0; P.nq0 = 256 * (sub & 1) + 32 * wave; P.t0 = wave >> 1; P.ntw = 3; }
        else { P.gbase0 = base + 2 * sub; P.gstep = 1; P.dil = 16; P.L = SEQ / 16; P.nk0 = 0; P.tpg = 2; P.ntl = 4; P.wgrp = wave >> 2; P.nq0 = 32 * (wave & 3); P.t0 = 2 * (wave >> 2); P.ntw = 2; }
        f32x16 o[2]; SM st;
        attn_resident_unit(P, lds, QO + h * 64, 1024, WSP(bf16, X_KA) + h * 64, 256, WSP(bf16, X_VA) + h * 64, 256, o, st, wave, lane);
        const float lt = xhalf_sum(st.l); const int qrow = P.q_row(r32);
        store_o(OAw + ((size_t)p * M + qrow) * 256 + h * 64, o, fast_rcp(lt), hi);
        if (hi == 0) LSEw[((size_t)p * M + qrow) * 4 + h] = st.mref + __log2f(lt);
    }
}

__device__ __forceinline__ void combine_phase(const Frame& F0, const ArgView& A, int l) {
    FRAME_TID(F0);
    bf16* QO = WSP(bf16, X_QO); const bf16* OA = (const bf16*)A.out(); const float* LSE = (const float*)((unsigned char*)A.out() + 24 * MiB);
    const int l16 = F.tid & 15, grp = F.tid >> 4;
    const int gpw = 4 * M / F.G;
    for (int g0 = F.vcu * gpw; g0 < (F.vcu + 1) * gpw; g0 += 32) {
        const int g = g0 + grp, r = g >> 2, h = g & 3;
        const float l0 = LSE[((size_t)0 * M + r) * 4 + h], l1 = LSE[((size_t)1 * M + r) * 4 + h], l2 = LSE[((size_t)2 * M + r) * 4 + h];
        const float mx = fmaxf(l0, fmaxf(l1, l2)), w0 = fast_exp2(l0 - mx), w1 = fast_exp2(l1 - mx), w2 = fast_exp2(l2 - mx), iw = fast_rcp(w0 + w1 + w2);
        const f32x4 a = ldbf4(OA + ((size_t)0 * M + r) * 256 + h * 64 + l16 * 4), b = ldbf4(OA + ((size_t)1 * M + r) * 256 + h * 64 + l16 * 4), c = ldbf4(OA + ((size_t)2 * M + r) * 256 + h * 64 + l16 * 4);
        stbf4(QO + (size_t)r * 1024 + h * 64 + l16 * 4, (a * w0 + b * w1 + c * w2) * iw);
    }
    {
        const float* p = A.in(I_P) + (size_t)l * M * PLE; bf16* pb = WSP(bf16, WS_PB);
        const int ipw = M * PLE / 8 / F.G;
        for (int i = F.vcu * ipw + F.tid; i < (F.vcu + 1) * ipw; i += NTHREADS) {
            const f32x4 a = *(const GAS f32x4*)(p + (size_t)i * 8), b = *(const GAS f32x4*)(p + (size_t)i * 8 + 4);
            v4u o; o.x = pk2(a.x, a.y); o.y = pk2(a.z, a.w); o.z = pk2(b.x, b.y); o.w = pk2(b.z, b.w);
            *(GAS v4u*)(pb + (size_t)i * 8) = o;
        }
    }
}

__device__ __forceinline__ void attn_phase(const Frame& F0, const ArgView& A, int l, bool dummy, bool gm, const XcdBarrier& bar, unsigned gx) {
    FRAME_TID(F0);
    using namespace att;
    const bf16* QO = WSP(bf16, X_QO); bf16* QOw = dummy ? WSP(bf16, WS_HBB) : WSP(bf16, X_QO);
    bf16* OAw = (bf16*)A.out(); float* LSEw = (float*)((unsigned char*)A.out() + 24 * MiB);
    const int wave = F.wave, lane = F.lane, r32 = lane & 31, hi = lane >> 5;
    const int bh = F.vcu >> 3, sub = F.vcu & 7, b = bh >> 2, h = bh & 3, base = b * SEQ;
    LAS unsigned char* lds = F.lds;
    if (!gm) combine_phase(F0, A, l);
#ifndef PROBE_SEL
#define PROBE_SEL 15
#endif
    LAS unsigned char* wlds = lds + wave * 16384;
    LAS float* rp = (LAS float*)(lds + XL_OFF);
    {
        const float* rpb = A.in(I_RPB) + ((size_t)l * 4 + h) * 15 * 31;
        for (int i = F.tid; i < 15 * 31; i += NTHREADS) rp[i] = rpb[i] * LOG2E;
        __syncthreads();
    }
    if (!dummy || (PROBE_SEL & 8)) {
        PolNAW P; P.base = base; P.R = 4 * sub + (wave >> 1); P.cb = 32 * (wave & 1); P.rpb = rp;
        { int s0 = P.R - 4; P.ks = s0 < 0 ? 0 : (s0 > 24 ? 24 : s0); }
        P.init_mask(r32, hi);
        f32x16 o[2]; SM st;
        attn_wave_unit<PolNAW>(P, wlds, QO + 768 + h * 64, 1024, WSP(bf16, X_KD) + h * 64, 256, WSP(bf16, X_VD) + h * 64, 256, o, st, lane);
        store_o(QOw + (size_t)P.q_row(r32) * 1024 + 768 + h * 64, o, fast_rcp(xhalf_sum(st.l)), hi);
    }
    __syncthreads();
    if (gm) grp_wait(bar, gx, 0u, 32u * (unsigned)(l + 1));
    if (!dummy || (PROBE_SEL & 2)) {
        PolDense P; P.base = base; P.q0 = base + 256 * sub;
        f32x16 o[2]; SM st;
        attn_unit<6, PolDense>(P, lds, WSP(bf16, X_QB) + h * 96, 384, WSP(bf16, X_KB) + h * 96, 384, WSP(bf16, X_VB) + h * 64, 256, o, st, wave, lane);
        store_o(QOw + (size_t)P.q_row(wave, r32) * 1024 + 256 + h * 64, o, fast_rcp(xhalf_sum(st.l)), hi);
    }
    if (!dummy || (PROBE_SEL & 4)) {
        float c08 = 0.8f, c06 = 0.6f; asm volatile("" : "+s"(c08), "+s"(c06));
        const float lam_init = c08 - c06 * fast_exp2(-0.3f * LOG2E * (float)l);
        float lam;
        { const float* lq1 = A.in(I_LQ1) + l * 32; const float* lk1 = A.in(I_LK1) + l * 32; const float* lq2 = A.in(I_LQ2) + l * 32; const float* lk2 = A.in(I_LK2) + l * 32;
          const float a = wave_sum(lane < 32 ? lq1[r32] * lk1[r32] : 0.f), bb = wave_sum(lane < 32 ? lq2[r32] * lk2[r32] : 0.f);
          lam = fast_exp2(a * LOG2E) - fast_exp2(bb * LOG2E) + lam_init; }
        PolDense P; P.base = base; P.q0 = base + 256 * sub;
        f32x16 o[2][2]; SM st[2]; float lsum[2];
        attn_unit_c<PolDense>(P, lds, QO + 512 + h * 64, 1024, WSP(bf16, X_KC) + h * 64, 256, WSP(bf16, X_VC) + h * 64, 256, o, st, wave, lane);
        lsum[0] = st[0].l; lsum[1] = st[1].l;
        const float i1 = fast_rcp(xhalf_sum(lsum[0])), i2 = lam * fast_rcp(xhalf_sum(lsum[1]));
        float ss = 0.f;
#pragma unroll
        for (int d0 = 0; d0 < 2; ++d0)
#pragma unroll
            for (int r = 0; r < 16; ++r) { const float v = o[0][d0][r] * i1 - o[1][d0][r] * i2; o[0][d0][r] = v; ss += v * v; }
        ss = xhalf_sum(ss);
        const float rs = (1.0f - lam_init) / sqrtf(ss * (1.0f / 64.0f) + 1e-5f);
        const float* subln = A.in(I_SUBLN) + l * 64;
#pragma unroll
        for (int d0 = 0; d0 < 2; ++d0)
#pragma unroll
            for (int g = 0; g < 4; ++g) { const f32x4 gs = *(const GAS f32x4*)(subln + 32 * d0 + 8 * g + 4 * hi);
#pragma unroll
                for (int e = 0; e < 4; ++e) o[0][d0][4 * g + e] *= gs[e]; }
        store_o(QOw + (size_t)P.q_row(wave, r32) * 1024 + 512 + h * 64, o[0], rs, hi);
    }
    if (gm) { grp_wait(bar, gx, 1u, 32u * (unsigned)(l + 1)); combine_phase(F0, A, l); }
}


#ifndef PHASE_MASK
#define PHASE_MASK 0x7ff
#endif
#define PH_ON(k) (((PHASE_MASK) >> (k)) & 1)
__global__ void __launch_bounds__(NTHREADS, 2) fwd_kernel(Args A) {
    extern __shared__ __attribute__((aligned(16))) unsigned char lds[];
    Frame F;
    F.lds = (LAS unsigned char*)lds;
    F.tid = threadIdx.x; F.lane = F.tid & 63; F.wave = __builtin_amdgcn_readfirstlane(F.tid >> 6);
    F.G = gridDim.x; { const int bx = blockIdx.x; F.vcu = (F.G % 8 == 0) ? (bx % 8) * (F.G / 8) + bx / 8 : bx; }
    F.ws = A.ws;
    volatile LAS unsigned* MISC = (volatile LAS unsigned*)(F.lds + MISC_OFF);
    for (int u = F.tid; u < (LDS_BYTES - LDSCTL_OFF) / 4; u += NTHREADS) ((LAS unsigned*)(F.lds + LDSCTL_OFF))[u] = 0u;
    __syncthreads();
    XcdBarrier bar; bar.wave = F.wave; bar.bar = (unsigned*)(A.ws + WS_CTL) + CW_BAR; bar.x = 0; bar.st = nullptr;
    if (MK_SINGLE) bar = xcd_barrier_post((unsigned*)(A.ws + WS_CTL) + CW_BAR, MISC + 8, F.wave);
    LAS unsigned char* ring = F.lds;
    F.tid = 0; F.lane = 0;
    int c = (int)blockIdx.x; const int G = F.G; const int vcu0 = F.vcu, wave0 = F.wave; unsigned char* const ws0 = A.ws; const int ph_lo = A.ph_lo, ph_hi = A.ph_hi;

    for (int ph = ph_lo; ph < ph_hi; ++ph) {
#ifdef PROBE_DUP
        constexpr int SPL = PH_PER_LAYER + 1;
        int l = (ph - 1) / SPL; const int j_ = (ph - 1) - l * SPL; const int k = (ph == 0) ? -1 : ((j_ <= PROBE_DUP) ? j_ : j_ - 1); const bool dry = (ph > 0 && j_ == PROBE_DUP);
        const bool is_final = (ph == DEPTH * SPL + 1);
#else
        int l = (ph - 1) / PH_PER_LAYER; const int k = (ph == 0) ? -1 : (ph - 1) - l * PH_PER_LAYER; constexpr bool dry = false; const bool is_final = (ph == N_PHASES - 1);
#endif
        ArgView AV; AV.kp = (const __attribute__((address_space(4))) unsigned char*)__builtin_amdgcn_kernarg_segment_ptr(); asm volatile("" : "+s"(AV.kp));
        { int c_ = (int)blockIdx.x; unsigned char* w_ = ws0; int v_ = vcu0, wv_ = wave0; asm volatile("" : "+s"(c_), "+s"(w_), "+s"(v_), "+s"(wv_), "+s"(l));
          c = c_; F.ws = w_; F.vcu = v_; F.wave = wv_; }
        unsigned char* const wl = F.ws + WS_W + (size_t)l * W_STRIDE;
        if (is_final) { if (PH_ON(10)) final_phase(F, AV); }
        else switch (k) {
        case -1: if (PH_ON(9)) prologue_phase(F, AV); break;
        case 0: if (PH_ON(0)) {
            pg8::Gemm g{WSP(pg8::bf16_t, WS_HBA), (pg8::bf16_t*)(wl + W_1T), M, N1, 1024}; pg8::StaticOrder S; S.init(M, N1, G, c);
            epi::EpiIn E{F.ws, (PG8_LAS float*)(F.lds + RSL_OFF)};
            pg8::gemm_phase<epi::EpiIn, pg8::StaticOrder, true, true>(ring, g, S, E, F.wave);
        } break;
        case 1: if (PH_ON(1)) {
            const int half = G / 2; const bool uq = c < half;
            pg8::Gemm g; g.A = uq ? WSP(pg8::bf16_t, X_CQ) : WSP(pg8::bf16_t, X_CKV); g.Bt = (pg8::bf16_t*)(wl + (uq ? W_UQT : W_UKVT)); g.M = M; g.N = 512; g.K = uq ? 384 : 256;
            pg8::StaticOrder S; S.init(M, 512, half, uq ? c : c - half);
            epi::EpiMla E{uq ? 0 : 1, F.ws};
            pg8::gemm_phase<epi::EpiMla, pg8::StaticOrder, true, true>(ring, g, S, E, F.wave);
            const bool gm1 = MK_SINGLE && __builtin_amdgcn_readfirstlane(MISC[10]) != 0u;
            if (gm1) grp_arrive(bar, (unsigned)c & 7u, 0u); else __syncthreads();
            attn_a_phase(F, AV, l);
            if (gm1) grp_arrive(bar, (unsigned)c & 7u, 1u);
        } break;
        case 2: if (PH_ON(2)) { const bool gm2 = MK_SINGLE && __builtin_amdgcn_readfirstlane(MISC[10]) != 0u; attn_phase(F, AV, l, dry, gm2, bar, (unsigned)c & 7u); } break;
        case 3: break;
        case 4: if (PH_ON(4)) {
            pg8::Gemm g{WSP(pg8::bf16_t, X_QO), (pg8::bf16_t*)(wl + W_OT), M, 1024, 1024}; pg8::StaticOrder S; S.init(M, 1024, G, c);
            epi::EpiRes E{WSP(pg8::bf16_t, WS_HBA), WSP(pg8::bf16_t, WS_HBB), WSP(float, WS_SSQB), dry};
            pg8::gemm_phase<epi::EpiRes, pg8::StaticOrder, true, true>(ring, g, S, E, F.wave);
        } break;
        case 5: if (PH_ON(5)) {
            { const int rem_ = ((M / 256) * (NUP / 256)) % G;
              if (c >= rem_) { if (l + 1 < DEPTH) convert_next_layer(F, AV, l + 1, c - rem_, G - rem_);
                  else {
                      pg8::Gemm g2{WSP(pg8::bf16_t, WS_PB), (pg8::bf16_t*)(wl + W_PPT), M, 1024, 256}; pg8::StaticOrder S2; S2.init(M, 1024, G - rem_, c - rem_);
                      epi::EpiSpill E2{WSP(pg8::bf16_t, X_ESC)};
                      pg8::gemm_phase<epi::EpiSpill, pg8::StaticOrder, true, true>(ring, g2, S2, E2, F.wave); } } }
            pg8::Gemm g{WSP(pg8::bf16_t, WS_HBB), (pg8::bf16_t*)(wl + W_UPT), M, NUP, 1024}; pg8::StaticOrder S; S.init(M, NUP, G, c);
            epi::EpiUpConv E{WSP(float, WS_SSQB), WSP(pg8::bf16_t, WS_ACT), WSP(float, WS_HALO), AV.in(I_CONV_W) + (size_t)l * 3 * NUP, AV.in(I_CONV_B) + (size_t)l * NUP, (PG8_LAS float*)(F.lds + XL_OFF), (PG8_LAS float*)(F.lds + CWL_OFF), (PG8_LAS float*)(F.lds + RSL_OFF)};
            pg8::gemm_phase<epi::EpiUpConv, pg8::StaticOrder, true, true>(ring, g, S, E, F.wave);
        } break;
        case 6: if (PH_ON(5)) fixup_phase(F, AV, l); break;
        case 7: if (PH_ON(7)) {
            pg8::Gemm g{WSP(pg8::bf16_t, WS_ACT), (pg8::bf16_t*)(wl + W_DNT), M, 1024, DFF}; pg8::StaticOrder S; S.init(M, 1024, G, c);
            epi::EpiRes E{WSP(pg8::bf16_t, WS_HBB), WSP(pg8::bf16_t, WS_HBB), WSP(float, WS_SSQC), dry};
            pg8::gemm_phase<epi::EpiRes, pg8::StaticOrder, true, true>(ring, g, S, E, F.wave);
        } break;
        default: if (PH_ON(8)) {
            pg8::bf16_t* esc = WSP(pg8::bf16_t, X_ESC) + (size_t)F.vcu * 65536;
            if (l + 1 < DEPTH) { pg8::Gemm g{WSP(pg8::bf16_t, WS_PB), (pg8::bf16_t*)(wl + W_PPT), M, 1024, 256}; pg8::StaticOrder S; S.init(M, 1024, G, c);
              epi::EpiSpill E{WSP(pg8::bf16_t, X_ESC)};
              pg8::gemm_phase<epi::EpiSpill, pg8::StaticOrder, true, true>(ring, g, S, E, F.wave); }
            { pg8::Gemm g{WSP(pg8::bf16_t, WS_HBB), (pg8::bf16_t*)(wl + W_GT), M, 1024, 1024}; pg8::StaticOrder S; S.init(M, 1024, G, c);
              epi::EpiPle E{WSP(float, WS_SSQC), esc, WSP(pg8::bf16_t, WS_HBB), WSP(pg8::bf16_t, WS_HBA), WSP(float, WS_SSQA), dry};
              pg8::gemm_phase<epi::EpiPle, pg8::StaticOrder, true, true>(ring, g, S, E, F.wave); }
        } break;
        }
        if (ph + 1 < ph_hi && (k != 3 || is_final) && !(MK_SINGLE && k == 1 && !is_final && __builtin_amdgcn_readfirstlane(MISC[10]) != 0u)) {
#if defined(PROBE_DUP) || !MK_SINGLE
            xcd_barrier(bar);
#else
            unsigned gm_ = MISC[10]; gm_ = __builtin_amdgcn_readfirstlane(gm_);
            if (gm_ != 0u && k >= 0 && !is_final) grp_barrier(bar, (unsigned)c & 7u, 32u  , (unsigned)ph + 1u,
                                                              (k == 4) ? (unsigned)(1 + PH_PER_LAYER * l + 2) + 1u : (k >= 8) ? (unsigned)(1 + PH_PER_LAYER * l + 7) + 1u : 0u, false);
            else xcd_barrier(bar);
            if (ph == 0) { if (F.wave == 0) { const unsigned m_ = grp_mode(bar.bar, G); if (pg8::lane_now() == 0) MISC[10] = m_; } __syncthreads(); }
#endif
        }
    }
}

extern "C" void kernel_launch(void* const* d_in, const int* in_sizes, int n_in, void* d_out, int out_size, void* d_ws, size_t ws_size, hipStream_t stream) {
    static int grid = 0;
    if (grid == 0) {
        if (n_in != 24 || out_size != M * DMODEL || ws_size < WS_END) { fprintf(stderr, "kernel_launch: unexpected problem (n_in %d, out %d, ws %zu; need ws >= %zu)\n", n_in, out_size, ws_size, (size_t)WS_END); grid = -1; return; }
        int dev = 0, cus = 0, per_cu = 0;
        if (hipGetDevice(&dev) != hipSuccess || hipDeviceGetAttribute(&cus, hipDeviceAttributeMultiprocessorCount, dev) != hipSuccess) { grid = -1; return; }
        if (hipFuncSetAttribute((const void*)fwd_kernel, hipFuncAttributeMaxDynamicSharedMemorySize, LDS_BYTES) != hipSuccess) { fprintf(stderr, "kernel_launch: hipFuncSetAttribute failed\n"); grid = -1; return; }
        if (hipOccupancyMaxActiveBlocksPerMultiprocessor(&per_cu, (const void*)fwd_kernel, NTHREADS, LDS_BYTES) != hipSuccess || per_cu < 1) { fprintf(stderr, "kernel_launch: occupancy query says %d blocks per CU\n", per_cu); (void)hipGetLastError(); grid = -1; return; }
        grid = cus;
    }
    if (grid < 0) return;
    if (hipMemsetAsync((char*)d_ws + WS_CTL, 0, CTL_ZERO_BYTES, stream) != hipSuccess) return;
    Args a{};
    for (int i = 0; i < 24; ++i) a.in[i] = (const float*)d_in[i];
    a.out = (float*)d_out; a.ws = (unsigned char*)d_ws;
#if MK_SINGLE
    a.ph_lo = 0; a.ph_hi = N_PHASES;
#ifdef PROBE_DUP
    a.ph_hi = DEPTH * (PH_PER_LAYER + 1) + 2;
#endif
    hipLaunchKernelGGL(fwd_kernel, dim3(grid), dim3(NTHREADS), LDS_BYTES, stream, a);
#else
    for (int ph = 0; ph < N_PHASES; ++ph) {
        a.ph_lo = ph; a.ph_hi = ph + 1;
        hipLaunchKernelGGL(fwd_kernel, dim3(grid), dim3(NTHREADS), LDS_BYTES, stream, a);
    }
#endif
}
```
